# Optimizing an MI355X kernel written in HIP

```python
import jax, jax.numpy as jnp
from jax import lax
import numpy as np

D_MODEL = 1024
BATCH = 2
SEQ = 8192
DEPTH = 2

EPS = 1e-6
RWKV_HEADS = 8
RWKV_HEAD_DIM = 64
RWKV_DIM = RWKV_HEADS * RWKV_HEAD_DIM
DECAY_LORA = 64
AAA_LORA = 64
GATE_LORA = 160
RWKV_IN = 3 * RWKV_DIM + DECAY_LORA + AAA_LORA + GATE_LORA
GN_EPS = 64e-5
MLA_HEADS = 4
MLA_NOPE = 64
MLA_ROPE = 32
MLA_QK = MLA_NOPE + MLA_ROPE
MLA_V = 64
MLA_DIM = MLA_HEADS * MLA_V
Q_LORA = 192
KV_LORA = 128
MLA_IN = Q_LORA + KV_LORA + MLA_ROPE
ROPE_THETA = 10000.0
Q_BLOCK = 128
GMLP_GROUPS = 4
GMLP_GROUP_DIM = 64
GMLP_DIM = GMLP_GROUPS * GMLP_GROUP_DIM
CHUNK = 128
GMLP_IN = 2 * GMLP_DIM
N_IN = RWKV_IN + MLA_IN + GMLP_IN
D_MIX = RWKV_DIM + MLA_DIM + GMLP_DIM
MEM_TOKENS = 256
MEM_HEADS = 4
MEM_HEAD_DIM = 64
MEM_DIM = MEM_HEADS * MEM_HEAD_DIM
N_GROUPS = 4
EXPERTS_PER_GROUP = 8
N_EXPERTS = N_GROUPS * EXPERTS_PER_GROUP
TOP_K = 2
D_EXPERT = 512
MOE_BLOCK = 128

kernel_name = 'hybrid_rwkv7_mla_gmlp_memxattn_hmoe'


def rms_norm(x, g, eps=EPS):
    xf = x.astype(jnp.float32)
    y = xf * lax.rsqrt(jnp.mean(xf * xf, axis=-1, keepdims=True) + eps)
    return (y * g.astype(jnp.float32)).astype(x.dtype)


def token_shift(p, mu):
    prev = jnp.concatenate([jnp.zeros_like(p[:, :1]), p[:, :-1]], axis=1)
    return p + (prev - p) * mu


def rope(x, pos):
    half = x.shape[-1] // 2
    inv = ROPE_THETA ** (-jnp.arange(half, dtype=jnp.float32) * 2.0 / x.shape[-1])
    ang = pos.astype(jnp.float32)[..., None] * inv
    cos = jnp.cos(ang)[:, :, None, :]
    sin = jnp.sin(ang)[:, :, None, :]
    xf = x.astype(jnp.float32)
    x1, x2 = xf[..., :half], xf[..., half:]
    return jnp.concatenate([x1 * cos - x2 * sin, x2 * cos + x1 * sin], axis=-1).astype(x.dtype)


def rwkv7_scan(r, w, k, v, a_, b_):
    B, S, H, N = r.shape
    def step(state, inp):
        r_t, w_t, k_t, v_t, a_t, b_t = inp
        sa = jnp.einsum('bhvk,bhk->bhv', state, a_t)
        state = (state * w_t[:, :, None, :] + sa[..., None] * b_t[:, :, None, :]
                 + v_t[..., None] * k_t[:, :, None, :])
        return state, jnp.einsum('bhvk,bhk->bhv', state, r_t)
    init = jnp.zeros((B, H, N, N), jnp.float32)
    xs = tuple(jnp.moveaxis(t, 1, 0) for t in (r, w, k, v, a_, b_))
    _, ys = lax.scan(step, init, xs)
    return jnp.moveaxis(ys, 0, 1)


def rwkv7_mixer(p, w0, w_up, a0, a_up, g_up, k_k, k_a, r_k, ln_g, ln_b):
    B, S, _ = p.shape
    H, N = RWKV_HEADS, RWKV_HEAD_DIM
    r, k, v, wd, ad, gd = jnp.split(p, np.cumsum([RWKV_DIM, RWKV_DIM, RWKV_DIM, DECAY_LORA, AAA_LORA]).tolist(), axis=-1)
    f32 = jnp.float32
    w_pre = (w0 + jnp.tanh(wd) @ w_up).astype(f32)
    w_log = -jax.nn.softplus(-w_pre) - 0.5
    decay = jnp.exp(-jnp.exp(w_log))
    a = jax.nn.sigmoid((a0 + ad @ a_up).astype(f32))
    g = jax.nn.sigmoid(gd) @ g_up
    hs = lambda t: t.astype(f32).reshape(B, S, H, N)
    r, k, v, decay, a = hs(r), hs(k), hs(v), hs(decay), hs(a)
    kk = k * k_k.astype(f32).reshape(H, N)
    kk = kk / jnp.maximum(jnp.sqrt(jnp.sum(kk * kk, axis=-1, keepdims=True)), 1e-12)
    k = k * (1.0 + (a - 1.0) * k_a.astype(f32).reshape(H, N))
    y = rwkv7_scan(r, decay, k, v, -kk, kk * a)
    mean = jnp.mean(y, axis=-1, keepdims=True)
    var = jnp.mean(jnp.square(y - mean), axis=-1, keepdims=True)
    y = (y - mean) * lax.rsqrt(var + GN_EPS) * ln_g.astype(f32).reshape(H, N) + ln_b.astype(f32).reshape(H, N)
    y = y + jnp.sum(r * k * r_k.astype(f32), axis=-1, keepdims=True) * v
    return (y.reshape(B, S, RWKV_DIM) * g.astype(f32)).astype(p.dtype)


def causal_block_attention(q, k, v):
    B, S, H, Dq = q.shape
    Dv = v.shape[-1]
    nb = S // Q_BLOCK
    qb = q.reshape(B, nb, Q_BLOCK, H, Dq).transpose(1, 0, 2, 3, 4)
    k_pos = jnp.arange(S)
    scale = Dq ** -0.5
    def one(args):
        q_blk, i = args
        s = jnp.einsum('bqhd,bkhd->bhqk', q_blk, k).astype(jnp.float32) * scale
        q_pos = i * Q_BLOCK + jnp.arange(Q_BLOCK)
        s = jnp.where(k_pos[None, :] <= q_pos[:, None], s, -jnp.inf)
        pr = jax.nn.softmax(s, axis=-1).astype(v.dtype)
        return jnp.einsum('bhqk,bkhd->bqhd', pr, v)
    out = lax.map(one, (qb, jnp.arange(nb)))
    return out.transpose(1, 0, 2, 3, 4).reshape(B, S, H * Dv)


def mla_mixer(p, positions, q_norm_g, w_uq, kv_norm_g, w_ukv, q_g, k_g):
    B, S, _ = p.shape
    H = MLA_HEADS
    c_q, c_kv, k_r = jnp.split(p, [Q_LORA, Q_LORA + KV_LORA], axis=-1)
    q = (rms_norm(c_q, q_norm_g) @ w_uq).reshape(B, S, H, MLA_QK)
    kv = (rms_norm(c_kv, kv_norm_g) @ w_ukv).reshape(B, S, H, MLA_NOPE + MLA_V)
    k_nope, v = kv[..., :MLA_NOPE], kv[..., MLA_NOPE:]
    q = jnp.concatenate([q[..., :MLA_NOPE], rope(q[..., MLA_NOPE:], positions)], axis=-1)
    k_rope = jnp.broadcast_to(rope(k_r[:, :, None, :], positions), (B, S, H, MLA_ROPE))
    k = jnp.concatenate([k_nope, k_rope], axis=-1)
    q = rms_norm(q, q_g)
    k = rms_norm(k, k_g)
    return causal_block_attention(q, k, v)


def gmlp_mixer(p, v_norm_g, ws, b):
    B, S, _ = p.shape
    G, Dg = GMLP_GROUPS, GMLP_GROUP_DIM
    z = jax.nn.gelu(p)
    u, v = z[..., :GMLP_DIM], z[..., GMLP_DIM:]
    v = rms_norm(v.reshape(B, S, G, Dg), v_norm_g.reshape(G, Dg))
    v = v.reshape(B, S // CHUNK, CHUNK, G, Dg)
    ws_c = ws * jnp.tril(jnp.ones((CHUNK, CHUNK), ws.dtype))
    sv = jnp.einsum('gts,bcsgd->bctgd', ws_c, v) + b.T[None, None, :, :, None]
    return u * sv.reshape(B, S, GMLP_DIM)


def memory_cross_attention(h, mem_k, mem_v, w_q, q_g, w_o):
    B, S, _ = h.shape
    q = rms_norm((h @ w_q).reshape(B, S, MEM_HEADS, MEM_HEAD_DIM), q_g)
    s = jnp.einsum('bqhd,bkhd->bhqk', q, mem_k).astype(jnp.float32) * (MEM_HEAD_DIM ** -0.5)
    pr = jax.nn.softmax(s, axis=-1).astype(mem_v.dtype)
    o = jnp.einsum('bhqk,bkhd->bqhd', pr, mem_v).reshape(B, S, MEM_DIM)
    return o @ w_o


def grouped_expert_ffn(t, eid, gate, w1, w3, w2):
    N, D = t.shape
    M = eid.shape[0]
    E, BLK = N_EXPERTS, MOE_BLOCK
    tok = jnp.repeat(jnp.arange(N, dtype=jnp.int32), TOP_K)
    order = jnp.argsort(eid)
    s_eid, s_tok, s_gate = eid[order], tok[order], gate[order]
    counts = jnp.bincount(eid, length=E)
    offsets = jnp.cumsum(counts) - counts
    padded = ((counts + BLK - 1) // BLK) * BLK
    p_end = jnp.cumsum(padded)
    p_off = p_end - padded
    dest = p_off[s_eid] + (jnp.arange(M) - offsets[s_eid])
    n_blocks = (M + E * (BLK - 1) + BLK - 1) // BLK
    P = n_blocks * BLK
    row_tok = jnp.full((P,), N, jnp.int32).at[dest].set(s_tok)
    row_gate = jnp.zeros((P,), gate.dtype).at[dest].set(s_gate)
    blk_e = jnp.minimum(jnp.searchsorted(p_end, jnp.arange(n_blocks) * BLK, side='right'), E - 1)
    t_pad = jnp.concatenate([t, jnp.zeros((1, D), t.dtype)], axis=0)
    def one(args):
        rows, e = args
        xb = t_pad[rows]
        hb = jax.nn.silu(xb @ w1[e]) * (xb @ w3[e])
        return hb @ w2[e]
    yb = lax.map(one, (row_tok.reshape(n_blocks, BLK), blk_e)).reshape(P, D)
    yb = yb * row_gate[:, None]
    return jax.ops.segment_sum(yb, row_tok, num_segments=N + 1)[:N]


def hierarchical_moe(h, w_group, b_group, w_expert, b_expert, w1, w3, w2):
    B, S, D = h.shape
    N = B * S
    t = h.reshape(N, D)
    g_prob = jax.nn.softmax((t @ w_group).astype(jnp.float32) + b_group.astype(jnp.float32), axis=-1)
    g_idx = jnp.argmax(g_prob, axis=-1)
    g_w = jnp.take_along_axis(g_prob, g_idx[:, None], axis=-1)[:, 0]
    e_logits = ((t @ w_expert).astype(jnp.float32) + b_expert.astype(jnp.float32)).reshape(N, N_GROUPS, EXPERTS_PER_GROUP)
    e_logits = jnp.take_along_axis(e_logits, g_idx[:, None, None], axis=1)[:, 0]
    e_prob = jax.nn.softmax(e_logits, axis=-1)
    top_p, top_i = lax.top_k(e_prob, TOP_K)
    gate = g_w[:, None] * top_p / jnp.sum(top_p, axis=-1, keepdims=True)
    eid = (g_idx[:, None] * EXPERTS_PER_GROUP + top_i).astype(jnp.int32)
    y = grouped_expert_ffn(t, eid.reshape(-1), gate.reshape(-1), w1, w3, w2)
    return y.reshape(B, S, D).astype(h.dtype)


def setup_inputs(seed: int = 0) -> dict:
    key = jax.random.key(seed)
    ks = jax.random.split(key, 41)
    nrm = lambda k, shape, s: jax.random.normal(k, shape, jnp.float32) * s
    gain = lambda k, shape: 1.0 + 0.05 * jax.random.normal(k, shape, jnp.float32)
    L = DEPTH
    positions = (jax.random.randint(ks[2], (BATCH, 1), 0, 4096)
                 + jnp.arange(SEQ, dtype=jnp.int32)[None, :]).astype(jnp.int32)
    return {
        'x': nrm(ks[0], (BATCH, SEQ, D_MODEL), 1.0),
        'mem': nrm(ks[1], (BATCH, MEM_TOKENS, D_MODEL), 1.0),
        'positions': positions,
        'norm_mix_g': gain(ks[3], (L, D_MODEL)),
        'w_in': nrm(ks[4], (L, D_MODEL, N_IN), D_MODEL ** -0.5),
        'shift_mu': jax.random.uniform(ks[5], (L, RWKV_IN), jnp.float32),
        'rwkv_w0': -0.5 + nrm(ks[6], (L, RWKV_DIM), 0.5),
        'rwkv_w_up': nrm(ks[7], (L, DECAY_LORA, RWKV_DIM), 0.5 * DECAY_LORA ** -0.5),
        'rwkv_a0': nrm(ks[8], (L, RWKV_DIM), 0.1),
        'rwkv_a_up': nrm(ks[9], (L, AAA_LORA, RWKV_DIM), 0.5 * AAA_LORA ** -0.5),
        'rwkv_g_up': nrm(ks[10], (L, GATE_LORA, RWKV_DIM), GATE_LORA ** -0.5),
        'rwkv_k_k': 0.85 + nrm(ks[11], (L, RWKV_DIM), 0.05),
        'rwkv_k_a': gain(ks[12], (L, RWKV_DIM)),
        'rwkv_r_k': nrm(ks[13], (L, RWKV_HEADS, RWKV_HEAD_DIM), 0.1),
        'rwkv_ln_g': gain(ks[14], (L, RWKV_DIM)),
        'rwkv_ln_b': nrm(ks[15], (L, RWKV_DIM), 0.02),
        'mla_q_norm_g': gain(ks[16], (L, Q_LORA)),
        'mla_w_uq': nrm(ks[17], (L, Q_LORA, MLA_HEADS * MLA_QK), Q_LORA ** -0.5),
        'mla_kv_norm_g': gain(ks[18], (L, KV_LORA)),
        'mla_w_ukv': nrm(ks[19], (L, KV_LORA, MLA_HEADS * (MLA_NOPE + MLA_V)), KV_LORA ** -0.5),
        'mla_q_g': gain(ks[20], (L, MLA_QK)),
        'mla_k_g': gain(ks[21], (L, MLA_QK)),
        'gmlp_v_norm_g': gain(ks[22], (L, GMLP_DIM)),
        'gmlp_ws': nrm(ks[23], (L, GMLP_GROUPS, CHUNK, CHUNK), CHUNK ** -0.5),
        'gmlp_b': gain(ks[24], (L, GMLP_GROUPS, CHUNK)),
        'w_out': nrm(ks[25], (L, D_MIX, D_MODEL), D_MIX ** -0.5),
        'mem_norm_g': gain(ks[26], (D_MODEL,)),
        'mem_w_kv': nrm(ks[27], (D_MODEL, 2 * MEM_DIM), D_MODEL ** -0.5),
        'mem_k_g': gain(ks[28], (MEM_HEAD_DIM,)),
        'norm_mem_g': gain(ks[29], (L, D_MODEL)),
        'mem_w_q': nrm(ks[30], (L, D_MODEL, MEM_DIM), D_MODEL ** -0.5),
        'mem_q_g': gain(ks[31], (L, MEM_HEAD_DIM)),
        'mem_w_o': nrm(ks[32], (L, MEM_DIM, D_MODEL), MEM_DIM ** -0.5),
        'norm_ffn_g': gain(ks[33], (L, D_MODEL)),
        'moe_w_group': nrm(ks[34], (L, D_MODEL, N_GROUPS), D_MODEL ** -0.5),
        'moe_b_group': nrm(ks[35], (L, N_GROUPS), 0.01),
        'moe_w_expert': nrm(ks[36], (L, D_MODEL, N_EXPERTS), D_MODEL ** -0.5),
        'moe_b_expert': nrm(ks[37], (L, N_EXPERTS), 0.01),
        'moe_w1': nrm(ks[38], (L, N_EXPERTS, D_MODEL, D_EXPERT), D_MODEL ** -0.5),
        'moe_w3': nrm(ks[39], (L, N_EXPERTS, D_MODEL, D_EXPERT), D_MODEL ** -0.5),
        'moe_w2': nrm(ks[40], (L, N_EXPERTS, D_EXPERT, D_MODEL), D_EXPERT ** -0.5),
    }


def reference(x, mem, positions, norm_mix_g, w_in, shift_mu, rwkv_w0, rwkv_w_up, rwkv_a0, rwkv_a_up,
              rwkv_g_up, rwkv_k_k, rwkv_k_a, rwkv_r_k, rwkv_ln_g, rwkv_ln_b, mla_q_norm_g, mla_w_uq,
              mla_kv_norm_g, mla_w_ukv, mla_q_g, mla_k_g, gmlp_v_norm_g, gmlp_ws, gmlp_b, w_out,
              mem_norm_g, mem_w_kv, mem_k_g, norm_mem_g, mem_w_q, mem_q_g, mem_w_o, norm_ffn_g,
              moe_w_group, moe_b_group, moe_w_expert, moe_b_expert, moe_w1, moe_w3, moe_w2):
    B, S, _ = x.shape
    M = mem.shape[1]
    mkv = (rms_norm(mem, mem_norm_g) @ mem_w_kv).reshape(B, M, 2, MEM_HEADS, MEM_HEAD_DIM)
    mem_k = rms_norm(mkv[:, :, 0], mem_k_g)
    mem_v = mkv[:, :, 1]
    for l in range(DEPTH):
        h = rms_norm(x, norm_mix_g[l])
        proj = h @ w_in[l]
        p_r, p_m, p_g = jnp.split(proj, [RWKV_IN, RWKV_IN + MLA_IN], axis=-1)
        o_r = rwkv7_mixer(token_shift(p_r, shift_mu[l]), rwkv_w0[l], rwkv_w_up[l], rwkv_a0[l], rwkv_a_up[l],
                          rwkv_g_up[l], rwkv_k_k[l], rwkv_k_a[l], rwkv_r_k[l], rwkv_ln_g[l], rwkv_ln_b[l])
        o_m = mla_mixer(p_m, positions, mla_q_norm_g[l], mla_w_uq[l], mla_kv_norm_g[l], mla_w_ukv[l],
                        mla_q_g[l], mla_k_g[l])
        o_g = gmlp_mixer(p_g, gmlp_v_norm_g[l], gmlp_ws[l], gmlp_b[l])
        x = x + jnp.concatenate([o_r, o_m, o_g], axis=-1) @ w_out[l]
        h = rms_norm(x, norm_mem_g[l])
        x = x + memory_cross_attention(h, mem_k, mem_v, mem_w_q[l], mem_q_g[l], mem_w_o[l])
        h = rms_norm(x, norm_ffn_g[l])
        x = x + hierarchical_moe(h, moe_w_group[l], moe_b_group[l], moe_w_expert[l], moe_b_expert[l],
                                 moe_w1[l], moe_w3[l], moe_w2[l])
    return x
```

```cpp
#include <hip/hip_runtime.h>
#include <cstdio>
#include <cstdint>
namespace pg8 {
#define PG8_LAS __attribute__((address_space(3)))
typedef unsigned short bf16_t;
typedef short bf16x8 __attribute__((ext_vector_type(8)));
typedef float f32x4 __attribute__((ext_vector_type(4)));
typedef unsigned u32x4 __attribute__((ext_vector_type(4)));
constexpr int BM = 256, BK = 64, HALF = 128, HTB = HALF * BK * 2  , STAGE_BYTES = 8 * HTB, NXCD = 8, WGM = 8;

__host__ __device__ __forceinline__ int lds_byte(int r, int c) { const int st = (r >> 4) * 2 + (c >> 5), rr = r & 15, cc = c & 31, ob = rr * 64 + cc * 2; return st * 1024 + (ob ^ (((ob >> 9) & 1) << 5)); }
__host__ __device__ __forceinline__ void stage_rc(int b, int& R, int& C) { const int st = b / 1024, sb = b % 1024, swz = sb ^ (((sb >> 9) & 1) << 5); R = (st >> 1) * 16 + swz / 64; C = (st & 1) * 32 + (swz % 64) / 2; }
__host__ __device__ __forceinline__ int perm32(int rho) { const int n = rho >> 4, i = rho & 15; return 8 * (i >> 2) + 4 * n + (i & 3); }

struct Unit { int pm, pn; };
struct Gemm { const bf16_t* A; const bf16_t* Bt; int M, N, K; const PG8_LAS unsigned* gt = nullptr; };

struct StaticOrder {
    int nM, nN, nwg, G, c;
    __host__ __device__ void init(int M, int N, int G_, int c_) { nM = M / BM; nN = N / BM; nwg = nM * nN; G = G_; c = c_; }
    __host__ __device__ bool next(int i, Unit& u) const {
        const long L = (long)i * G + c; if (L >= nwg) return false;
        int wgid = (int)L; { const int q = nwg / NXCD, r = nwg % NXCD, xcd = wgid % NXCD, off = wgid / NXCD; wgid = (xcd < r ? xcd * (q + 1) : r * (q + 1) + (xcd - r) * q) + off; }
        const int nig = WGM * nN, gid = wgid / nig, fm = gid * WGM, gsz = (nM - fm) < WGM ? (nM - fm) : WGM;
        u.pm = fm + ((wgid % nig) % gsz); u.pn = (wgid % nig) / gsz; return true;
    }
    __device__ __forceinline__ void a_ready(const Unit&) const {}
    __device__ __forceinline__ void done(const Unit&) const {}
};

__device__ __forceinline__ unsigned cvt_pk_bf16(float lo, float hi) { unsigned r; asm volatile("v_cvt_pk_bf16_f32 %0, %1, %2" : "=v"(r) : "v"(lo), "v"(hi)); return r; }
typedef float f32x2 __attribute__((ext_vector_type(2)));
__device__ __forceinline__ f32x2 gelu_pk(f32x2 v) {
    const f32x2 av = __builtin_elementwise_abs(v), d = av * 0.2316418882f + 1.0f;
    f32x2 t; t.x = __builtin_amdgcn_rcpf(d.x); t.y = __builtin_amdgcn_rcpf(d.y);
    f32x2 q = t * 0.5307027145f + (-0.7265760135f); q = q * t + 0.7107068705f; q = q * t + (-0.142248368f); q = q * t + 0.127414796f; q = q * t;
    const f32x2 s = (v * v) * (-0.72134752044f);
    f32x2 e; e.x = __builtin_amdgcn_exp2f(s.x); e.y = __builtin_amdgcn_exp2f(s.y);
    const f32x2 m = v * (q * e), r = v - m;
    f32x2 o; o.x = v.x < 0.f ? m.x : r.x; o.y = v.y < 0.f ? m.y : r.y; return o;
}

template <int ACT  > struct EpiBf16 {
    static constexpr bool PERM = true, AFTER_DRAIN = false; static_assert(ACT == 0 || ACT == 1, "EpiBf16: ACT is 0 (none) or 1 (gelu_pk)");
    bf16_t* O; int ldc; const float* bias; int split_cols; size_t split_stride; float scale0;
    int coh_tile = -1;
    __device__ __forceinline__ void operator()(const f32x4 (&acc)[2][2][4][2], const Unit& u, int wr, int wc, int fr, int fq) const {
        const int row0 = u.pm * BM + wr * 64 + fr; int colt = u.pn * BM; bf16_t* base = O;
        float sc = 1.f; if (split_cols) { const int t = colt / split_cols; base += (size_t)t * split_stride; colt -= t * split_cols; if (t == 0) sc = scale0; }
        const int col0 = colt + wc * 32 + 8 * fq, bcol0 = u.pn * BM + wc * 32 + 8 * fq;
        f32x4 bv[2][2];
#pragma unroll
        for (int bj = 0; bj < 2; ++bj)
#pragma unroll
            for (int n = 0; n < 2; ++n) bv[bj][n] = bias ? *(const f32x4*)(bias + bcol0 + bj * HALF + 4 * n) : (f32x4){0.f, 0.f, 0.f, 0.f};
#pragma unroll
        for (int ai = 0; ai < 2; ++ai)
#pragma unroll
            for (int m = 0; m < 4; ++m) { bf16_t* rowp = base + (size_t)(row0 + ai * HALF + m * 16) * ldc + col0;
#pragma unroll
                for (int bj = 0; bj < 2; ++bj) { f32x4 v0 = acc[ai][bj][m][0] + bv[bj][0], v1 = acc[ai][bj][m][1] + bv[bj][1];
                    if (ACT == 1) { f32x2 a = gelu_pk((f32x2){v0[0], v0[1]}), b = gelu_pk((f32x2){v0[2], v0[3]}), c = gelu_pk((f32x2){v1[0], v1[1]}), d = gelu_pk((f32x2){v1[2], v1[3]});
                        v0 = (f32x4){a.x, a.y, b.x, b.y}; v1 = (f32x4){c.x, c.y, d.x, d.y}; }
                    v0 = v0 * sc; v1 = v1 * sc; u32x4 w; w.x = cvt_pk_bf16(v0[0], v0[1]); w.y = cvt_pk_bf16(v0[2], v0[3]); w.z = cvt_pk_bf16(v1[0], v1[1]); w.w = cvt_pk_bf16(v1[2], v1[3]);
                    if (u.pm == coh_tile) { unsigned long long* q_ = (unsigned long long*)(rowp + bj * HALF);
                        __hip_atomic_store(q_, (unsigned long long)w.x | ((unsigned long long)w.y << 32), __ATOMIC_RELAXED, __HIP_MEMORY_SCOPE_AGENT);
                        __hip_atomic_store(q_ + 1, (unsigned long long)w.z | ((unsigned long long)w.w << 32), __ATOMIC_RELAXED, __HIP_MEMORY_SCOPE_AGENT); }
                    else *(u32x4*)(rowp + bj * HALF) = w; } }
    }
};

struct EpiF32 {
    static constexpr bool PERM = false, AFTER_DRAIN = false;
    float* C; int ldc;
    __device__ __forceinline__ void operator()(const f32x4 (&acc)[2][2][4][2], const Unit& u, int wr, int wc, int fr, int fq) const {
        const int row0 = u.pm * BM + wr * 64 + fr, col0 = u.pn * BM + wc * 32 + 4 * fq;
#pragma unroll
        for (int ai = 0; ai < 2; ++ai)
#pragma unroll
            for (int m = 0; m < 4; ++m) { float* rowp = C + (size_t)(row0 + ai * HALF + m * 16) * ldc + col0;
#pragma unroll
                for (int bj = 0; bj < 2; ++bj)
#pragma unroll
                    for (int n = 0; n < 2; ++n) *(f32x4*)(rowp + bj * HALF + n * 16) = acc[ai][bj][m][n]; }
    }
};
struct EpiResF32 {
    static constexpr bool PERM = false, AFTER_DRAIN = false;
    const float* base; float* out; int ldc;
    __device__ __forceinline__ void operator()(const f32x4 (&acc)[2][2][4][2], const Unit& u, int wr, int wc, int fr, int fq) const {
        const int row0 = u.pm * BM + wr * 64 + fr, col0 = u.pn * BM + wc * 32 + 4 * fq;
#pragma unroll
        for (int ai = 0; ai < 2; ++ai)
#pragma unroll
            for (int m = 0; m < 4; ++m) { const size_t ro = (size_t)(row0 + ai * HALF + m * 16) * ldc + col0;
#pragma unroll
                for (int bj = 0; bj < 2; ++bj)
#pragma unroll
                    for (int n = 0; n < 2; ++n) { const f32x4 b = *(const f32x4*)(base + ro + bj * HALF + n * 16); *(f32x4*)(out + ro + bj * HALF + n * 16) = acc[ai][bj][m][n] + b; } }
    }
};
struct EpiResXB {
    static constexpr bool PERM = false, AFTER_DRAIN = false;
    const float* base; float* out; bf16_t* xb; int ldc;
    __device__ __forceinline__ void operator()(const f32x4 (&acc)[2][2][4][2], const Unit& u, int wr, int wc, int fr, int fq) const {
        const int row0 = u.pm * BM + wr * 64 + fr, col0 = u.pn * BM + wc * 32 + 4 * fq;
#pragma unroll
        for (int ai = 0; ai < 2; ++ai)
#pragma unroll
            for (int m = 0; m < 4; ++m) { const size_t ro = (size_t)(row0 + ai * HALF + m * 16) * ldc + col0;
#pragma unroll
                for (int bj = 0; bj < 2; ++bj)
#pragma unroll
                    for (int n = 0; n < 2; ++n) { const f32x4 v = acc[ai][bj][m][n] + *(const f32x4*)(base + ro + bj * HALF + n * 16); *(f32x4*)(out + ro + bj * HALF + n * 16) = v;
                        const unsigned long long w_ = (unsigned long long)cvt_pk_bf16(v[0], v[1]) | ((unsigned long long)cvt_pk_bf16(v[2], v[3]) << 32); *(unsigned long long*)(xb + ro + bj * HALF + n * 16) = w_; } }
    }
};
struct EpiBf16Rs {
    static constexpr bool PERM = true, AFTER_DRAIN = false;
    bf16_t* O; int ldc; const float* rss;
    __device__ __forceinline__ void operator()(const f32x4 (&acc)[2][2][4][2], const Unit& u, int wr, int wc, int fr, int fq) const {
        const int row0 = u.pm * BM + wr * 64 + fr, col0 = u.pn * BM + wc * 32 + 8 * fq;
#pragma unroll
        for (int ai = 0; ai < 2; ++ai)
#pragma unroll
            for (int m = 0; m < 4; ++m) { const int row = row0 + ai * HALF + m * 16; bf16_t* rowp = O + (size_t)row * ldc + col0;
                const float rs = rsqrtf(rss[row] * (1.0f / 1024.0f) + 1e-6f);
#pragma unroll
                for (int bj = 0; bj < 2; ++bj) { const f32x4 v0 = acc[ai][bj][m][0] * rs, v1 = acc[ai][bj][m][1] * rs;
                    u32x4 w; w.x = cvt_pk_bf16(v0[0], v0[1]); w.y = cvt_pk_bf16(v0[2], v0[3]); w.z = cvt_pk_bf16(v1[0], v1[1]); w.w = cvt_pk_bf16(v1[2], v1[3]);
                    *(u32x4*)(rowp + bj * HALF) = w; } }
    }
};
struct EpiSwiGLU {
    static constexpr bool PERM = true, AFTER_DRAIN = false;
    bf16_t* H; int ldh;
    __device__ __forceinline__ void operator()(const f32x4 (&acc)[2][2][4][2], const Unit& u, int wr, int wc, int fr, int fq) const {
        const int row0 = u.pm * BM + wr * 64 + fr, col0 = (u.pn & 3) * HALF + wc * 32 + 8 * fq;
#pragma unroll
        for (int ai = 0; ai < 2; ++ai)
#pragma unroll
            for (int m = 0; m < 4; ++m) { bf16_t* rowp = H + (size_t)(row0 + ai * HALF + m * 16) * ldh + col0;
                float o[8];
#pragma unroll
                for (int n = 0; n < 2; ++n)
#pragma unroll
                    for (int j = 0; j < 4; ++j) { const float a = acc[ai][0][m][n][j], b = acc[ai][1][m][n][j]; o[n * 4 + j] = a / (1.0f + __expf(-a)) * b; }
                u32x4 w; w.x = cvt_pk_bf16(o[0], o[1]); w.y = cvt_pk_bf16(o[2], o[3]); w.z = cvt_pk_bf16(o[4], o[5]); w.w = cvt_pk_bf16(o[6], o[7]);
                *(u32x4*)rowp = w; }
    }
};
struct EpiMoeOut {
    static constexpr bool PERM = true, AFTER_DRAIN = false;
    bf16_t* Y; const int* rowtok; const float* rowgate;
    __device__ __forceinline__ void operator()(const f32x4 (&acc)[2][2][4][2], const Unit& u, int wr, int wc, int fr, int fq) const {
        const int row0 = u.pm * BM + wr * 64 + fr, col0 = (u.pn & 3) * BM + wc * 32 + 8 * fq;
#pragma unroll
        for (int ai = 0; ai < 2; ++ai)
#pragma unroll
            for (int m = 0; m < 4; ++m) { const int row = row0 + ai * HALF + m * 16; const int a = rowtok[row]; const float gt = rowgate[row];
                if (a >= 0) { bf16_t* rowp = Y + (size_t)a * 1024 + col0;
#pragma unroll
                    for (int bj = 0; bj < 2; ++bj) { const f32x4 v0 = acc[ai][bj][m][0] * gt, v1 = acc[ai][bj][m][1] * gt;
                        u32x4 w; w.x = cvt_pk_bf16(v0[0], v0[1]); w.y = cvt_pk_bf16(v0[2], v0[3]); w.z = cvt_pk_bf16(v1[0], v1[1]); w.w = cvt_pk_bf16(v1[2], v1[3]);
                        *(u32x4*)(rowp + bj * HALF) = w; } } }
    }
};
struct MoeOrder {
    int total, G, c; const PG8_LAS int* tbl;
    __device__ __forceinline__ bool next(int i, Unit& u) const {
        int L;
        if ((G & 7) == 0) { const int per = (total + 7) >> 3, x = c & 7, j = c >> 3, pos = i * (G >> 3) + j; if (pos >= per) return false; L = x * per + pos; if (L >= total) return false; }
        else { L = i * G + c; if (L >= total) return false; }
        const int rt = L >> 2, ct = L & 3;
        const int e = __builtin_amdgcn_readfirstlane(tbl[rt]);
        u.pm = rt; u.pn = e * 4 + ct; return true;
    }
    __device__ __forceinline__ void a_ready(const Unit&) const {}
    __device__ __forceinline__ void done(const Unit&) const {}
};

struct MoeOrderX {
    int rt0, U, rank, nloc, mode; const PG8_LAS int* tbl; unsigned* cnt;
    __device__ __forceinline__ bool next(int i, Unit& u) const {
        int p;
        const int r = U % nloc, L = nloc - r;
        if (mode == 0 || r == 0) p = i * nloc + rank;
        else if (rank >= r) p = (i < 2) ? i * L + (rank - r) : 2 * L + (i - 2) * nloc + (rank - r);
        else p = 2 * L + i * nloc + (L + rank);
        if (p >= U) return false;
        const int rt = rt0 + (p >> 2);
        const int e = __builtin_amdgcn_readfirstlane(tbl[rt]);
        u.pm = rt; u.pn = e * 4 + (p & 3); return true;
    }
    __device__ __forceinline__ void a_ready(const Unit& u) const {
        if (mode == 1) { unsigned* c = cnt + u.pm * 64; unsigned sp = 0u;
            while (__hip_atomic_load(c, __ATOMIC_RELAXED, __HIP_MEMORY_SCOPE_AGENT) < 32u) { __builtin_amdgcn_s_sleep(2); if (++sp > (1u << 22)) break; }
            asm volatile("" ::: "memory"); }
    }
    __device__ __forceinline__ void done(const Unit& u) const {
        if (mode == 0) { asm volatile("s_waitcnt vmcnt(0)" ::: "memory");
            if ((threadIdx.x & 63) == 0) __hip_atomic_fetch_add(cnt + u.pm * 64, 1u, __ATOMIC_RELAXED, __HIP_MEMORY_SCOPE_AGENT); }
    }
};

struct XOrder {
    int rt0, U, rank, nloc; unsigned* done_cnt; int ncol = 4;
    mutable int pend = -1;
    __device__ __forceinline__ bool next(int i, Unit& u) const { const int p = i * nloc + rank; if (p >= U) return false; const int q = p / ncol; u.pm = rt0 + q; u.pn = p - q * ncol; return true; }
    __device__ __forceinline__ void a_ready(const Unit&) const {}
    __device__ __forceinline__ void signal(int rt) const {
        if ((threadIdx.x & 63) == 0) __hip_atomic_fetch_add(done_cnt + rt * 64, 1u, __ATOMIC_RELAXED, __HIP_MEMORY_SCOPE_AGENT);
    }
    __device__ __forceinline__ void done(const Unit& u) const { if (pend >= 0) signal(pend); pend = u.pm; }
    __device__ __forceinline__ void flush() const { asm volatile("s_waitcnt vmcnt(0)" ::: "memory"); if (pend >= 0) signal(pend); pend = -1; }
};

template <class Epi, class Sched, bool ALIGN_EPI = false, bool SP2 = false, bool GATHER = false>
__device__ __forceinline__ void gemm_phase(PG8_LAS unsigned char* lds, const Gemm g, const Sched& S, const Epi& E) {
    int tid_ = threadIdx.x; asm volatile("" : "+v"(tid_));
    const int tid = tid_, wid = __builtin_amdgcn_readfirstlane(tid >> 6), lane = tid & 63, wr = wid >> 2, wc = wid & 3, fr = lane & 15, fq = lane >> 4;
    const int K = g.K, nt = K / BK;
    unsigned voffA[2], voffB[2];
#pragma unroll
    for (int i = 0; i < 2; ++i) { int R, C; stage_rc(tid * 16 + i * 8192, R, C); const int Rb = Epi::PERM ? ((R & ~31) + perm32(R & 31)) : R;
        voffA[i] = (unsigned)(R * K + C) * 2u; voffB[i] = (unsigned)(Rb * K + C) * 2u; }
    const size_t kstep = (size_t)(BK * 2);
    const size_t hstep = (size_t)HALF * K * 2;
    const size_t tstep = 2 * hstep;
    const unsigned ldsw = (unsigned)wid * 1024u;
    const int aoff = lds_byte(wr * 64 + fr, fq * 8), boff = lds_byte(wc * 32 + fr, fq * 8);
#define PG8_SA(b, h) (((b) * 2 + (h)) * HTB)
#define PG8_SB(b, h) ((4 + (b) * 2 + (h)) * HTB)
#define PG8_STAGE(bufoff, gbase, voff) do { _Pragma("unroll") for (int _i = 0; _i < 2; ++_i) \
        __builtin_amdgcn_global_load_lds((const unsigned*)((const char*)(gbase) + (voff)[_i]), (PG8_LAS unsigned*)(lds + (bufoff) + ldsw + _i * 8192), 16, 0, 0); } while (0)
#define PG8_LDA(dst, b, h) do { _Pragma("unroll") for (int m = 0; m < 4; ++m) _Pragma("unroll") for (int k = 0; k < 2; ++k) dst[m][k] = *(const PG8_LAS bf16x8*)(lds + PG8_SA(b, h) + aoff + m * 2048 + k * 1024); } while (0)
#define PG8_LDB(dst, b, h) do { _Pragma("unroll") for (int n = 0; n < 2; ++n) _Pragma("unroll") for (int k = 0; k < 2; ++k) dst[n][k] = *(const PG8_LAS bf16x8*)(lds + PG8_SB(b, h) + boff + n * 2048 + k * 1024); } while (0)
#define PG8_MMA(ai, bj, At, Bt) do { __builtin_amdgcn_s_setprio(1); _Pragma("unroll") for (int m = 0; m < 4; ++m) _Pragma("unroll") for (int n = 0; n < 2; ++n) _Pragma("unroll") for (int k = 0; k < 2; ++k) \
        acc[ai][bj][m][n] = __builtin_amdgcn_mfma_f32_16x16x32_bf16(Bt[n][k], At[m][k], acc[ai][bj][m][n], 0, 0, 0); __builtin_amdgcn_s_setprio(0); } while (0)
#define PG8_WAIT_V(n) asm volatile("s_waitcnt vmcnt(" #n ")" ::: "memory")
#define PG8_WAIT_L(n) asm volatile("s_waitcnt lgkmcnt(" #n ")" ::: "memory")
#define PG8_BAR __builtin_amdgcn_s_barrier()
#define PG8_SCHED __builtin_amdgcn_sched_barrier(0)
    static_assert(!GATHER || SP2, "GATHER is written for the SP2 loop");
    unsigned vG[2][2] = {{0u, 0u}, {0u, 0u}};
#define PG8_LOADG(u_) do { int t3_ = threadIdx.x; asm volatile("" : "+v"(t3_)); _Pragma("unroll") for (int i_ = 0; i_ < 2; ++i_) { int R_, C_; stage_rc(t3_ * 16 + i_ * 8192, R_, C_); \
        _Pragma("unroll") for (int h_ = 0; h_ < 2; ++h_) vG[h_][i_] = g.gt[(u_) * 256 + h_ * HALF + R_] + (unsigned)C_ * 2u; } } while (0)
#define PG8_STAGEA(bufoff, base, h) do { if constexpr (GATHER) PG8_STAGE(bufoff, base, vG[h]); else PG8_STAGE(bufoff, (base) + ((h) ? hstep : (size_t)0), voffA); } while (0)
    Unit cur, nxt; int ui = 0;
    if (!S.next(0, cur)) return;
    if constexpr (GATHER) PG8_LOADG(0);
    f32x4 acc[2][2][4][2];
#pragma unroll
    for (int a = 0; a < 2; ++a)
#pragma unroll
        for (int b = 0; b < 2; ++b)
#pragma unroll
            for (int m = 0; m < 4; ++m)
#pragma unroll
                for (int n = 0; n < 2; ++n) acc[a][b][m][n] = (f32x4){0.f, 0.f, 0.f, 0.f};
    bf16x8 At[4][2], B0[2][2], B1[2][2];
    const char* cA = (const char*)g.A + (GATHER ? (size_t)0 : (size_t)cur.pm * tstep); const char* cB = (const char*)g.Bt + (size_t)cur.pn * tstep;
    S.a_ready(cur);
    if constexpr (SP2) {
        PG8_STAGE(PG8_SB(0, 0), cB, voffB); PG8_STAGE(PG8_SB(0, 1), cB + hstep, voffB); PG8_STAGEA(PG8_SA(0, 0), cA, 0); PG8_STAGEA(PG8_SA(0, 1), cA, 1);
        if (wr == 1) PG8_BAR;
        PG8_WAIT_V(2); PG8_BAR;
        PG8_STAGE(PG8_SB(1, 0), cB + kstep, voffB); PG8_STAGEA(PG8_SA(1, 0), cA + kstep, 0); PG8_STAGE(PG8_SB(1, 1), cB + hstep + kstep, voffB);
        PG8_WAIT_V(6); PG8_BAR;
    } else {
        PG8_STAGE(PG8_SB(0, 0), cB, voffB); PG8_STAGE(PG8_SA(0, 0), cA, voffA); PG8_STAGE(PG8_SB(0, 1), cB + hstep, voffB); PG8_STAGE(PG8_SA(0, 1), cA + hstep, voffA);
        if (wr == 1) PG8_BAR;
        PG8_WAIT_V(4); PG8_BAR;
        PG8_STAGE(PG8_SB(1, 0), cB + kstep, voffB); PG8_STAGE(PG8_SA(1, 0), cA + kstep, voffA); PG8_STAGE(PG8_SB(1, 1), cB + hstep + kstep, voffB);
        PG8_WAIT_V(6); PG8_BAR;
    }
    for (;;) {
        const bool has_next = S.next(ui + 1, nxt);
        const char* nA = (has_next && !GATHER) ? (const char*)g.A + (size_t)nxt.pm * tstep : cA; const char* nB = has_next ? (const char*)g.Bt + (size_t)nxt.pn * tstep : cB;
        for (int t = 0; t < nt; t += 2) {
            const bool last = (t == nt - 2);
            const char* a1 = cA + (size_t)(t + 1) * kstep;
            const char* a2 = last ? nA : cA + (size_t)(t + 2) * kstep; const char* b2 = last ? nB : cB + (size_t)(t + 2) * kstep;
            const char* a3 = a2 + kstep; const char* b3 = b2 + kstep;
            if (last && has_next) S.a_ready(nxt);
            if constexpr (SP2) {
            PG8_LDB(B0, 0, 0); PG8_LDB(B1, 0, 1); PG8_SCHED; PG8_LDA(At, 0, 0); PG8_STAGEA(PG8_SA(1, 1), a1, 1);
            if constexpr (GATHER) { if (last && has_next) PG8_LOADG(ui + 1); }
            PG8_WAIT_V(8); PG8_WAIT_L(0); PG8_BAR; PG8_MMA(0, 0, At, B0); PG8_MMA(0, 1, At, B1); PG8_BAR; PG8_SCHED;
            PG8_LDA(At, 0, 1); PG8_STAGE(PG8_SB(0, 0), b2, voffB); PG8_STAGE(PG8_SB(0, 1), b2 + hstep, voffB); PG8_STAGEA(PG8_SA(0, 0), a2, 0);
            PG8_WAIT_V(8); PG8_WAIT_L(0); PG8_BAR; PG8_MMA(1, 0, At, B0); PG8_MMA(1, 1, At, B1); PG8_BAR; PG8_SCHED;
            PG8_LDB(B0, 1, 0); PG8_LDB(B1, 1, 1); PG8_SCHED; PG8_LDA(At, 1, 0); PG8_STAGEA(PG8_SA(0, 1), a2, 1);
            PG8_WAIT_V(8); PG8_WAIT_L(0); PG8_BAR; PG8_MMA(0, 0, At, B0); PG8_MMA(0, 1, At, B1); PG8_BAR; PG8_SCHED;
            PG8_LDA(At, 1, 1); PG8_STAGE(PG8_SB(1, 0), b3, voffB); PG8_STAGE(PG8_SB(1, 1), b3 + hstep, voffB); PG8_STAGEA(PG8_SA(1, 0), a3, 0);
            PG8_WAIT_V(8); PG8_WAIT_L(0); PG8_BAR; PG8_MMA(1, 0, At, B0); PG8_MMA(1, 1, At, B1); PG8_BAR; PG8_SCHED;
            } else {
            PG8_LDB(B0, 0, 0); PG8_SCHED; PG8_LDA(At, 0, 0); PG8_STAGE(PG8_SA(1, 1), a1 + hstep, voffA);
            PG8_WAIT_L(8); PG8_BAR; PG8_WAIT_L(0); PG8_MMA(0, 0, At, B0); PG8_BAR; PG8_SCHED;
            PG8_LDB(B1, 0, 1); PG8_STAGE(PG8_SB(0, 0), b2, voffB);
            PG8_BAR; PG8_WAIT_L(0); PG8_MMA(0, 1, At, B1); PG8_BAR;
            PG8_LDA(At, 0, 1); PG8_STAGE(PG8_SA(0, 0), a2, voffA);
            PG8_BAR; PG8_WAIT_L(0); PG8_MMA(1, 0, At, B0); PG8_BAR; PG8_SCHED;
            PG8_STAGE(PG8_SB(0, 1), b2 + hstep, voffB);
            PG8_WAIT_V(6); PG8_BAR; PG8_MMA(1, 1, At, B1); PG8_BAR;
            PG8_LDB(B0, 1, 0); PG8_SCHED; PG8_LDA(At, 1, 0); PG8_STAGE(PG8_SA(0, 1), a2 + hstep, voffA);
            PG8_WAIT_L(8); PG8_BAR; PG8_WAIT_L(0); PG8_MMA(0, 0, At, B0); PG8_BAR; PG8_SCHED;
            PG8_LDB(B1, 1, 1); PG8_STAGE(PG8_SB(1, 0), b3, voffB);
            PG8_BAR; PG8_WAIT_L(0); PG8_MMA(0, 1, At, B1); PG8_BAR;
            PG8_LDA(At, 1, 1); PG8_STAGE(PG8_SA(1, 0), a3, voffA);
            PG8_BAR; PG8_WAIT_L(0); PG8_MMA(1, 0, At, B0); PG8_BAR; PG8_SCHED;
            PG8_STAGE(PG8_SB(1, 1), b3 + hstep, voffB);
            PG8_WAIT_V(6); PG8_BAR; PG8_MMA(1, 1, At, B1); PG8_BAR;
            }
        }
        if constexpr (ALIGN_EPI) { if (wr == 0) PG8_BAR; }
        if constexpr (!Epi::AFTER_DRAIN) { int t2_ = threadIdx.x; asm volatile("" : "+v"(t2_)); const int fr_ = t2_ & 15, fq_ = (t2_ >> 4) & 3;
            E(acc, cur, wr, wc, fr_, fq_); S.done(cur); }
        if (!has_next) break;
#pragma unroll
        for (int a = 0; a < 2; ++a)
#pragma unroll
            for (int b = 0; b < 2; ++b)
#pragma unroll
                for (int m = 0; m < 4; ++m)
#pragma unroll
                    for (int n = 0; n < 2; ++n) acc[a][b][m][n] = (f32x4){0.f, 0.f, 0.f, 0.f};
        cur = nxt; cA = nA; cB = nB; ++ui;
        if constexpr (ALIGN_EPI) { if (wr == 1) PG8_BAR; }
    }
    PG8_WAIT_V(0);
    if constexpr (!ALIGN_EPI) { if (wr == 0) PG8_BAR; }
    PG8_BAR;
    if constexpr (Epi::AFTER_DRAIN) { E.fused(acc, cur, wr, wc, fr, fq, lds, wid, lane); S.done(cur); }
#undef PG8_SA
#undef PG8_SB
#undef PG8_STAGE
#undef PG8_STAGEA
#undef PG8_LOADG
#undef PG8_LDA
#undef PG8_LDB
#undef PG8_MMA
#undef PG8_WAIT_V
#undef PG8_WAIT_L
#undef PG8_BAR
#undef PG8_SCHED
}
}

#ifndef PG8_SP2
#define PG8_SP2 true
#endif
#ifndef PG8_ALIGN
#define PG8_ALIGN true
#endif

constexpr int NWAVES = 8, NTHR = 512;
constexpr int BATCH = 2, SEQ = 8192, M = BATCH * SEQ, D = 1024, DEPTH = 2;
constexpr int NIN = 2688, NINP = 2816;
constexpr int RW_R0 = 0, RW_K0 = 512, RW_V0 = 1024, RW_WD0 = 1536, RW_AD0 = 1600, RW_GD0 = 1664, RW_IN = 1824;
constexpr int ML_CQ0 = 1824, ML_CKV0 = 2016, ML_KR0 = 2144;
constexpr int GM_U0 = 2176, GM_V0 = 2432;
constexpr int MIX_MLA0 = 512, MIX_GM0 = 768;
constexpr int NEXP = 32, PROWS = 40960;
constexpr float EPS = 1e-6f, GN_EPS = 64e-5f;

constexpr size_t MiB = 1u << 20;
constexpr size_t WS_CTL = 0, CTL_ZERO_BYTES = 1 * MiB;
constexpr size_t WS_MKV = 1 * MiB;
constexpr size_t WS_EID = 2 * MiB, WS_GATE = WS_EID + 128 * 1024, WS_ROWTOK = WS_GATE + 128 * 1024, WS_ROWGATE = WS_ROWTOK + 160 * 1024;
constexpr size_t WS_WRT = 3 * MiB;
constexpr int RW_KS = 1152;
constexpr size_t WS_MN = 4 * MiB;
constexpr size_t WS_WIN = 5 * MiB, WS_WOUT = 16 * MiB, WS_WMQ = 20 * MiB, WS_WMO = 21 * MiB, WS_WMKV = 22 * MiB;
constexpr size_t WS_W13 = 23 * MiB, WS_W2 = 151 * MiB;
constexpr size_t WS_XN = 215 * MiB, WS_MIX = 247 * MiB, WS_Q2 = 279 * MiB, WS_O2 = 287 * MiB;
constexpr size_t WS_PROJ = 295 * MiB, WS_RWA = 383 * MiB, WS_RWG = 399 * MiB, WS_RWD = 415 * MiB, WS_MQ = 447 * MiB, WS_MK = 459 * MiB, WS_MV = 471 * MiB;
constexpr size_t WS_HS = 295 * MiB, WS_H = 375 * MiB, WS_YM = 415 * MiB;
constexpr size_t WS_END = 479 * MiB;
constexpr size_t WS_GWS = 2 * MiB + 640 * 1024;

constexpr size_t WS_MLAW = 511 * MiB;
constexpr int MLAW_L = 384 * 192 + 512 * 128;

constexpr size_t WS_LORA = 3 * MiB + 320 * 1024;
constexpr int LORA_L = 512 * 64 * 2 + 512 * 160, ACTP = 296;

static_assert(WS_HS + (size_t)PROWS * 1024 * 2 <= WS_H && WS_H + (size_t)PROWS * 512 * 2 <= WS_YM && WS_YM + (size_t)32768 * 1024 * 2 <= WS_END, "moe map");
constexpr int CW_BAR = 4096;
constexpr int CW_RSS = 65536;
constexpr int CW_CNT = 16384, CW_CUR = 16384 + 4096;
constexpr int CW_XC = 131072;
constexpr int CW_MD = 98304;
constexpr int GT_OFF = 131072, GT_UNITS = 4;
constexpr int RING_BYTES = 159744, LDSCTL_OFF = RING_BYTES, MISC_OFF = LDSCTL_OFF + 320, TBL_OFF = LDSCTL_OFF + 1024, LDS_BYTES = 163840;

#define GAS __attribute__((address_space(1)))
#define LAS __attribute__((address_space(3)))
typedef unsigned short bf16;
typedef unsigned v4u __attribute__((ext_vector_type(4)));
typedef unsigned v2u __attribute__((ext_vector_type(2)));
typedef float f32x4 __attribute__((ext_vector_type(4)));
#define LDS_WAIT() asm volatile("s_waitcnt lgkmcnt(0)" ::: "memory")
typedef float f32x2_t __attribute__((ext_vector_type(2)));
typedef __bf16 bf16x2_t __attribute__((ext_vector_type(2)));
__device__ __forceinline__ unsigned pk2(float lo, float hi) { const f32x2_t v = {lo, hi}; const bf16x2_t b = __builtin_convertvector(v, bf16x2_t); return __builtin_bit_cast(unsigned, b); }
__device__ __forceinline__ unsigned f2bf(float f) { return pk2(f, f) & 0xffffu; }
__device__ __forceinline__ float bf2f(unsigned b) { return __builtin_bit_cast(float, b << 16); }
__device__ __forceinline__ float bflo(unsigned w) { return __builtin_bit_cast(float, w << 16); }
__device__ __forceinline__ float bfhi(unsigned w) { return __builtin_bit_cast(float, w & 0xffff0000u); }
__device__ __forceinline__ float sigmoidf_(float x) { return __builtin_amdgcn_rcpf(1.0f + __expf(-x)); }
__device__ __forceinline__ float tanhf_(float x) { return 1.0f - 2.0f * __builtin_amdgcn_rcpf(1.0f + __expf(2.0f * x)); }
__device__ __forceinline__ float gelu_tanh(float x) { return x * sigmoidf_(1.5957691216057308f * (x + 0.044715f * x * x * x)); }
__device__ __forceinline__ float shx(float v, int o) {
    const int x = __builtin_bit_cast(int, v); int r;
    if (o == 1) r = __builtin_amdgcn_mov_dpp(x, 0xB1, 0xF, 0xF, true);
    else if (o == 2) r = __builtin_amdgcn_mov_dpp(x, 0x4E, 0xF, 0xF, true);
    else if (o == 4) r = __builtin_amdgcn_ds_swizzle(x, 0x101F);
    else if (o == 8) r = __builtin_amdgcn_ds_swizzle(x, 0x201F);
    else if (o == 16) r = __builtin_amdgcn_ds_swizzle(x, 0x401F);
    else { const auto p = __builtin_amdgcn_permlane32_swap((unsigned)x, (unsigned)x, false, false); r = (int)((threadIdx.x & 32u) ? p[0] : p[1]); }
    return __builtin_bit_cast(float, r);
}
__device__ __forceinline__ float wave_sum(float v) {
#pragma unroll
    for (int o = 1; o < 64; o <<= 1) v += shx(v, o);
    return v;
}

#define XB_TMO      128
#define XB_XCNT(j)  (256  + 64 * (j))
#define XB_XSUB(j)  (1280 + 64 * (j))
#define XB_XGEN(j)  (2304 + 64 * (j))
#define XB_TOP      3328
#define XB_TOPGEN   3392
#define XCD_BAR_WORDS 3456
#define XB_SPIN_CAP (1u << 23)
__device__ __forceinline__ unsigned xb_ld(unsigned* p)              { return __hip_atomic_load(p, __ATOMIC_RELAXED, __HIP_MEMORY_SCOPE_AGENT); }
__device__ __forceinline__ unsigned xb_add(unsigned* p, unsigned v) { return __hip_atomic_fetch_add(p, v, __ATOMIC_RELAXED, __HIP_MEMORY_SCOPE_AGENT); }
__device__ __forceinline__ unsigned xb_xcc_id() { return (unsigned)__builtin_amdgcn_s_getreg((3 << 11) | 20) & 0xFu; }
#define XB_SPIN(cond, bar) do { unsigned _sp = 0; while (cond) { __builtin_amdgcn_s_sleep(1); \
    if ((++_sp & 255u) == 0u) { if (xb_ld(&(bar)[XB_TMO])) break; if (_sp > XB_SPIN_CAP) { atomicAdd(&(bar)[XB_TMO], 1u); break; } } } } while (0)
struct XcdBarrier { unsigned* bar; unsigned x; volatile LAS unsigned* st; };
__device__ __forceinline__ XcdBarrier xcd_barrier_post(unsigned* bar, volatile LAS unsigned* st) {
    XcdBarrier b; b.bar = bar; b.x = xb_xcc_id(); b.st = st;
    if (threadIdx.x == 0) st[3] = xb_add(&bar[XB_XCNT(b.x)], 1u);
    return b;
}
__device__ __forceinline__ void xcd_barrier_complete(unsigned* bar, unsigned x, unsigned& nloc, unsigned& nx, unsigned& xi) {
    const unsigned G = gridDim.x * gridDim.y * gridDim.z;
    unsigned sum, cnt, mine, before, sp = 0u;
    for (;;) {
        sum = 0u; cnt = 0u; mine = 0u; before = 0u;
#pragma unroll
        for (unsigned j = 0; j < 16; ++j) { const unsigned c = xb_ld(&bar[XB_XCNT(j)]); sum += c; cnt += (c > 0u) ? 1u : 0u; mine = (j == x) ? c : mine; before += (j < x && c > 0u) ? 1u : 0u; }
        if (sum == G) break;
        __builtin_amdgcn_s_sleep(1);
        if ((++sp & 255u) == 0u) { if (xb_ld(&bar[XB_TMO])) break; if (sp > XB_SPIN_CAP) { atomicAdd(&bar[XB_TMO], 1u); break; } }
    }
    nloc = mine > 0u ? mine : 1u; nx = cnt > 0u ? cnt : 1u; xi = before;
}
template <bool LIGHT = false> __device__ __forceinline__ void xcd_barrier(const XcdBarrier& b) {
    asm volatile("s_waitcnt vmcnt(0)" ::: "memory");
    __syncthreads();
    if (threadIdx.x == 0) {
        unsigned* bar = b.bar;
        __builtin_amdgcn_s_waitcnt(0);
        unsigned nloc = b.st[0], nx = b.st[1];
        if (nloc == 0u) { unsigned xi; xcd_barrier_complete(bar, b.x, nloc, nx, xi); b.st[0] = nloc; b.st[1] = nx; b.st[2] = xi; }
        const unsigned old = xb_add(&bar[XB_XSUB(b.x)], 1u);
        const unsigned gen = old / nloc;
        if (old + 1u == (gen + 1u) * nloc) {
            if constexpr (!LIGHT) __builtin_amdgcn_fence(__ATOMIC_RELEASE, "agent");
            asm volatile("s_waitcnt vmcnt(0)" ::: "memory");
            const unsigned og = xb_add(&bar[XB_TOP], 1u);
            const unsigned tg = og / nx;
            if (og + 1u == (tg + 1u) * nx) xb_add(&bar[XB_TOPGEN], 1u);
            else XB_SPIN(xb_ld(&bar[XB_TOPGEN]) == tg, bar);
            if constexpr (!LIGHT) __builtin_amdgcn_fence(__ATOMIC_ACQUIRE, "agent");
            xb_add(&bar[XB_XGEN(b.x)], 1u);
            asm volatile("s_waitcnt vmcnt(0)" ::: "memory");
        } else {
            XB_SPIN(xb_ld(&bar[XB_XGEN(b.x)]) == gen, bar);
            if constexpr (!LIGHT) __builtin_amdgcn_fence(__ATOMIC_ACQUIRE, "agent");
            asm volatile("s_waitcnt vmcnt(0)" ::: "memory");
        }
    }
    __syncthreads();
}

struct Args { const void* in[41]; float* out; unsigned char* ws; int ph_lo, ph_hi; };
struct Frame {
    LAS unsigned char* lds; volatile LAS unsigned* MISC; GAS unsigned* ctl;
    int tid, lane, wave, bid, G;
    GAS unsigned char* ws; GAS float* out;
};

struct XDeal { int rt0, U, rank, nloc; };
__device__ __forceinline__ void xd_wait(unsigned* c, unsigned target = 32u) { unsigned sp = 0u;
    while (__hip_atomic_load(c, __ATOMIC_RELAXED, __HIP_MEMORY_SCOPE_AGENT) < target) { __builtin_amdgcn_s_sleep(2); if (++sp > (1u << 22)) break; }
    asm volatile("" ::: "memory"); }
__device__ __forceinline__ void xd_signal(unsigned* c) { asm volatile("s_waitcnt vmcnt(0)" ::: "memory");
    if ((threadIdx.x & 63) == 0) __hip_atomic_fetch_add(c, 1u, __ATOMIC_RELAXED, __HIP_MEMORY_SCOPE_AGENT); }

__device__ __forceinline__ void xd_block_done(unsigned* c) { if (threadIdx.x == 0) __hip_atomic_fetch_add(c, 1u, __ATOMIC_RELAXED, __HIP_MEMORY_SCOPE_AGENT); }
__device__ __forceinline__ void xd_wait_blocks(unsigned* c, unsigned target) {
    if (threadIdx.x == 0) { unsigned sp = 0u; while (__hip_atomic_load(c, __ATOMIC_RELAXED, __HIP_MEMORY_SCOPE_AGENT) < target) { __builtin_amdgcn_s_sleep(8); if (++sp > (1u << 21)) break; } }
    __syncthreads(); }

__device__ __forceinline__ bool xd_wait_proj(const XDeal& xd, unsigned* c1, int tile) {
    const int R = tile >> 2;
    xd_wait(c1 + R * 64, 88u);
    if ((tile & 3) == 0 && ((tile * 64) & (SEQ - 1)) != 0) { xd_wait(c1 + (R - 1) * 64, 88u); return R == xd.rt0; }
    return false;
}
__device__ __forceinline__ unsigned ld_bf16_dev(const bf16* p) {
    const unsigned long long a = (unsigned long long)p; const unsigned w = __hip_atomic_load((const unsigned*)(a & ~3ull), __ATOMIC_RELAXED, __HIP_MEMORY_SCOPE_AGENT);
    return (a & 2ull) ? (w >> 16) : (w & 0xffffu);
}

__device__ __forceinline__ void transpose_item(const float* W, int K, int N, bf16* WT, int rmul, int radd, LAS float* scr, int item, int lane, const float* gk = nullptr) {
    const int nblk = N / 32, kb = item / nblk, nb = item % nblk, k0 = 64 * kb, n0 = 32 * nb;
#pragma unroll 8
    for (int i = 0; i < 32; ++i) { const int kk = 2 * i + (lane >> 5); scr[kk * 33 + (lane & 31)] = W[(size_t)(k0 + kk) * N + n0 + (lane & 31)] * (gk ? gk[k0 + kk] : 1.0f); }
    LDS_WAIT(); asm volatile("" ::: "memory");
    const int c = lane & 7;
    const int rbase = (n0 / 128) * rmul + (n0 % 128) + radd;
#pragma unroll
    for (int j = 0; j < 4; ++j) { const int n = (lane >> 3) + 8 * j; const LAS float* s = scr + (8 * c) * 33 + n;
        v4u o; o.x = pk2(s[0 * 33], s[1 * 33]); o.y = pk2(s[2 * 33], s[3 * 33]); o.z = pk2(s[4 * 33], s[5 * 33]); o.w = pk2(s[6 * 33], s[7 * 33]);
        *(v4u*)(WT + (size_t)(rbase + n) * K + k0 + 8 * c) = o; }
    LDS_WAIT(); asm volatile("" ::: "memory");
}

__device__ __forceinline__ float norm_row(int lane, const float* xin, float* xout, const bf16* y0, const bf16* y1, const float* g, bf16* xn, f32x4 (&hv)[4]) {
    float ss = 0.f;
#pragma unroll
    for (int j = 0; j < 4; ++j) {
        f32x4 v = *(const f32x4*)(xin + 4 * lane + 256 * j);
        if (y0) { const v2u a = *(const v2u*)(y0 + 4 * lane + 256 * j), b = *(const v2u*)(y1 + 4 * lane + 256 * j);
            v.x += bflo(a.x) + bflo(b.x); v.y += bfhi(a.x) + bfhi(b.x); v.z += bflo(a.y) + bflo(b.y); v.w += bfhi(a.y) + bfhi(b.y); }
        if (xout) *(f32x4*)(xout + 4 * lane + 256 * j) = v;
        hv[j] = v; ss += (v.x * v.x + v.y * v.y) + (v.z * v.z + v.w * v.w);
    }
    const float rstd = rsqrtf(wave_sum(ss) * (1.0f / 1024.0f) + EPS);
#pragma unroll
    for (int j = 0; j < 4; ++j) { const f32x4 gg = g ? *(const f32x4*)(g + 4 * lane + 256 * j) : (f32x4){1.f, 1.f, 1.f, 1.f}; hv[j] = hv[j] * rstd * gg;
        if (xn) { v2u o; o.x = pk2(hv[j].x, hv[j].y); o.y = pk2(hv[j].z, hv[j].w); *(v2u*)(xn + 4 * lane + 256 * j) = o; } }
    return rstd;
}

__device__ __forceinline__ void p0_prologue(Frame& F, const Args& A) {
    LAS float* scr = (LAS float*)(F.lds + F.wave * 16384);
    const int gw = F.bid * NWAVES + F.wave, NGW = F.G * NWAVES;
    bf16* ws16 = (bf16*)F.ws;
    constexpr int I_IN = 16 * (NIN / 32), I_OUT = 16 * 32, I_MQ = 16 * 8, I_MO = 4 * 32, I_MKV = 16 * 16, I_W1 = 16 * 16, I_W2 = 8 * 32;
    constexpr int I_MOE = 2 * I_W1 + I_W2;
    constexpr int NITEMS = DEPTH * (I_IN + I_OUT + I_MQ + I_MO) + I_MKV + DEPTH * NEXP * I_MOE;
#pragma unroll 1
    for (int it = gw; it < NITEMS; it += NGW) {
        int r = it;
        if (r < DEPTH * I_IN) { const int l = r / I_IN; r %= I_IN; transpose_item((const float*)A.in[4] + (size_t)l * D * NIN, D, NIN, (bf16*)(F.ws + WS_WIN) + (size_t)l * NINP * D, 128, 0, scr, r, F.lane); continue; } r -= DEPTH * I_IN;
        if (r < DEPTH * I_OUT) { const int l = r / I_OUT; r %= I_OUT; transpose_item((const float*)A.in[25] + (size_t)l * D * D, D, D, (bf16*)(F.ws + WS_WOUT) + (size_t)l * D * D, 128, 0, scr, r, F.lane); continue; } r -= DEPTH * I_OUT;
        if (r < DEPTH * I_MQ) { const int l = r / I_MQ; r %= I_MQ; transpose_item((const float*)A.in[30] + (size_t)l * D * 256, D, 256, (bf16*)(F.ws + WS_WMQ) + (size_t)l * 256 * D, 128, 0, scr, r, F.lane, (const float*)A.in[29] + l * D); continue; } r -= DEPTH * I_MQ;
        if (r < DEPTH * I_MO) { const int l = r / I_MO; r %= I_MO; transpose_item((const float*)A.in[32] + (size_t)l * 256 * D, 256, D, (bf16*)(F.ws + WS_WMO) + (size_t)l * D * 256, 128, 0, scr, r, F.lane); continue; } r -= DEPTH * I_MO;
        if (r < I_MKV) { transpose_item((const float*)A.in[27], D, 512, (bf16*)(F.ws + WS_WMKV), 128, 0, scr, r, F.lane); continue; } r -= I_MKV;
        { const int le = r / I_MOE; r %= I_MOE;
          if (r < I_W1) { transpose_item((const float*)A.in[38] + (size_t)le * D * 512, D, 512, (bf16*)(F.ws + WS_W13) + (size_t)le * 1024 * D, 256, 0, scr, r, F.lane); continue; } r -= I_W1;
          if (r < I_W1) { transpose_item((const float*)A.in[39] + (size_t)le * D * 512, D, 512, (bf16*)(F.ws + WS_W13) + (size_t)le * 1024 * D, 256, 128, scr, r, F.lane); continue; } r -= I_W1;
          transpose_item((const float*)A.in[40] + (size_t)le * 512 * D, 512, D, (bf16*)(F.ws + WS_W2) + (size_t)le * D * 512, 128, 0, scr, r, F.lane); }
    }
    { const int gt = F.bid * NTHR + F.tid, NGT = F.G * NTHR;
#pragma clang loop vectorize(disable) interleave(disable) unroll(disable)
      for (int i = gt; i < DEPTH * 128 * (D / 8); i += NGT) { const int l = i / (128 * (D / 8)), rr = i % (128 * (D / 8));
          *(v4u*)((bf16*)(F.ws + WS_WIN) + (size_t)l * NINP * D + (size_t)NIN * D + (size_t)rr * 8) = (v4u){0u, 0u, 0u, 0u}; }
      bf16* wrf = (bf16*)(F.ws + WS_WRT);
#pragma clang loop vectorize(disable) interleave(disable) unroll(disable)
      for (int i = gt; i < DEPTH * 2 * 32 * RW_KS; i += NGT) { const int l = i / (2 * 32 * RW_KS), part = (i / (32 * RW_KS)) & 1, ks = (i / RW_KS) & 31, q = i % RW_KS;
          int j, kq; const int e = q & 7;
          if (q < 1024) { const int t = q >> 9, ln = (q >> 3) & 63; j = 16 * t + (ln & 15); kq = ln >> 4; } else { const int sl = (q - 1024) >> 3; j = 32 + (sl & 3); kq = sl >> 2; }
          const int c = 32 * ks + 8 * kq + e;
          const float wv = ((j < 4) ? ((const float*)A.in[34])[(size_t)l * 1024 * 4 + c * 4 + j] : ((const float*)A.in[36])[(size_t)l * 1024 * 32 + c * 32 + (j - 4)]) * ((const float*)A.in[33])[l * D + c];
          const unsigned short hi = f2bf(wv); const float hf = __builtin_bit_cast(float, (unsigned)hi << 16);
          wrf[i] = (bf16)(part ? f2bf(wv - hf) : hi); }
    }
    { const int gt = F.bid * NTHR + F.tid, NGT = F.G * NTHR; bf16* lw_ = (bf16*)(F.ws + WS_LORA);
#pragma clang loop vectorize(disable) interleave(disable) unroll(disable)
      for (int i = gt; i < DEPTH * LORA_L; i += NGT) { const int l = i / LORA_L, r = i % LORA_L; float v;
          if (r < 512 * 64) v = ((const float*)A.in[7])[(size_t)l * 64 * 512 + (r % 64) * 512 + r / 64];
          else if (r < 2 * 512 * 64) { const int q = r - 512 * 64; v = ((const float*)A.in[9])[(size_t)l * 64 * 512 + (q % 64) * 512 + q / 64]; }
          else { const int q = r - 2 * 512 * 64; v = ((const float*)A.in[10])[(size_t)l * 160 * 512 + (q % 160) * 512 + q / 160]; }
          lw_[i] = (bf16)f2bf(v); } }
    { const int gt = F.bid * NTHR + F.tid, NGT = F.G * NTHR; bf16* mw_ = (bf16*)(F.ws + WS_MLAW);
#pragma clang loop vectorize(disable) interleave(disable) unroll(disable)
      for (int i = gt; i < DEPTH * MLAW_L; i += NGT) { const int l = i / MLAW_L, r = i % MLAW_L; float v;
          if (r < 384 * 192) v = ((const float*)A.in[17])[(size_t)l * 192 * 384 + (r % 192) * 384 + r / 192];
          else { const int q = r - 384 * 192; v = ((const float*)A.in[19])[(size_t)l * 128 * 512 + (q % 128) * 512 + q / 128]; }
          mw_[i] = (bf16)f2bf(v); } }
    { const int gt = F.bid * NTHR + F.tid, NGT = F.G * NTHR; bf16* gw_ = (bf16*)(F.ws + WS_GWS);
#pragma clang loop vectorize(disable) interleave(disable) unroll(disable)
      for (int i = gt; i < DEPTH * 4 * 16384; i += NGT) { const int tt_ = (i >> 7) & 127, ss_ = i & 127; gw_[i] = (bf16)f2bf(ss_ <= tt_ ? ((const float*)A.in[23])[i] : 0.f); } }
    f32x4 hv[4];
#pragma unroll 1
    for (int m = gw; m < 512; m += NGW) norm_row(F.lane, (const float*)A.in[1] + (size_t)m * D, nullptr, nullptr, nullptr, (const float*)A.in[26], (bf16*)(F.ws + WS_MN) + (size_t)m * D, hv);
#pragma unroll 1
    for (int m = gw; m < M; m += NGW) norm_row(F.lane, (const float*)A.in[0] + (size_t)m * D, nullptr, nullptr, nullptr, (const float*)A.in[3], (bf16*)(F.ws + WS_XN) + (size_t)m * D, hv);
    (void)ws16;
}

typedef short bf16x8 __attribute__((ext_vector_type(8)));
constexpr int CP = 72;
constexpr int CMAT = 64 * CP * 2;
constexpr int CK_AT = 0, CK_BT = 1, CK_KT = 2, CK_RT = 3, CK_ATT = 4, CK_BHT = 5, CK_KHT = 6, CK_VT = 7, CK_AAK = 8, CK_ABRT = 9, CK_AKRT = 10;
constexpr int CK_SET0 = 11, CK_SET1 = 14;
constexpr int CK_GSUM_OFF = 17 * CMAT;
constexpr int CK_WC_OFF = CK_GSUM_OFF + 8 * 64 * 4;
static_assert(CK_WC_OFF + 256 <= RING_BYTES, "chunk prep LDS");
constexpr size_t WS_PT = WS_XN + 16 * MiB, WS_QB = WS_Q2, WS_S0 = 479 * MiB, WS_YL = 495 * MiB;
__device__ __forceinline__ size_t yrt_off(int tile, int h, int blk) { return ((size_t)(tile * 64 + h * 8 + blk)) * 1024; }
static_assert(WS_YL + 16 * MiB <= (size_t)512 * MiB, "ws map");

__device__ __forceinline__ f32x4 ck_tile(const LAS bf16* L, const LAS bf16* R, int n0, int m0, int lane) {
    const int r = lane & 15, kq = lane >> 4;
    f32x4 acc = (f32x4){0.f, 0.f, 0.f, 0.f};
#pragma unroll
    for (int ks = 0; ks < 2; ++ks) {
        const bf16x8 a = *(const LAS bf16x8*)(R + (m0 + r) * CP + ks * 32 + kq * 8);
        const bf16x8 b = *(const LAS bf16x8*)(L + (n0 + r) * CP + ks * 32 + kq * 8);
        acc = __builtin_amdgcn_mfma_f32_16x16x32_bf16(a, b, acc, 0, 0, 0);
    }
    return acc;
}
__device__ __forceinline__ v2u pack4(f32x4 v) { v2u o; o.x = pk2(v.x, v.y); o.y = pk2(v.z, v.w); return o; }
__device__ __forceinline__ f32x4 unpack4(v2u w) { return (f32x4){bflo(w.x), bfhi(w.x), bflo(w.y), bfhi(w.y)}; }

#define CK_RAWLOAD(hh_) do { const int c_ = (hh_) * 64 + (F.tid & 63); const int mf_ = tile * 64 + 8 * (F.tid >> 6); const bf16* P_ = (const bf16*)(F.ws + WS_PROJ); \
        if ((mf_ & (SEQ - 1)) == 0) { qp[0] = 0u; qp[1] = 0u; qp[2] = 0u; } else { const bf16* pp_ = P_ + (size_t)(mf_ - 1) * NINP; if (coh && (F.tid >> 6) == 0) { qp[0] = ld_bf16_dev(pp_ + RW_R0 + c_); qp[1] = ld_bf16_dev(pp_ + RW_K0 + c_); qp[2] = ld_bf16_dev(pp_ + RW_V0 + c_); } else { qp[0] = pp_[RW_R0 + c_]; qp[1] = pp_[RW_K0 + c_]; qp[2] = pp_[RW_V0 + c_]; } } \
        _Pragma("unroll") for (int i_ = 0; i_ < 8; ++i_) { const size_t m_ = (size_t)(mf_ + i_); const bf16* pp_ = P_ + m_ * NINP; qr[i_] = pp_[RW_R0 + c_]; qk[i_] = pp_[RW_K0 + c_]; qv[i_] = pp_[RW_V0 + c_]; \
            qw[i_] = ((const float*)(F.ws + WS_RWD))[m_ * 512 + c_]; qa[i_] = ((const bf16*)(F.ws + WS_RWA))[m_ * 512 + c_]; } } while (0)
__device__ __forceinline__ void chunk_prep_item(Frame& F, const Args& A, int l, int tile, int h, const bool coh, unsigned (&qr)[8], unsigned (&qk)[8], unsigned (&qv)[8], unsigned (&qa)[8], float (&qw)[8], unsigned (&qp)[3]) {
    LAS bf16* MT = (LAS bf16*)F.lds;
#define CKM(s) (MT + (s) * 64 * CP)
    LAS float* gsum = (LAS float*)(F.lds + CK_GSUM_OFF);
    LAS float* WCs = (LAS float*)(F.lds + CK_WC_OFF);
    const bf16* P = (const bf16*)(F.ws + WS_PROJ); const float* RWD = (const float*)(F.ws + WS_RWD); const bf16* RWA = (const bf16*)(F.ws + WS_RWA);
    const float* mu = (const float*)A.in[5] + l * RW_IN;
    const int ci = tile * 8 + h; const int m0 = tile * 64;
    bf16* YLg = (bf16*)(F.ws + WS_YL) + (size_t)ci * 4096;
    bf16* PTg = (bf16*)(F.ws + WS_PT) + (size_t)ci * 4096; bf16* QBg = (bf16*)(F.ws + WS_QB) + (size_t)ci * 4096; bf16* YRm = (bf16*)(F.ws + WS_MIX);
    const int ch = F.tid & 63, tg = F.tid >> 6;
    __syncthreads();
    {
        const int c = h * 64 + ch;
        const float mur = mu[RW_R0 + c], muk = mu[RW_K0 + c], muv = mu[RW_V0 + c];
        const float kkw = ((const float*)A.in[11])[l * 512 + c], kaw = ((const float*)A.in[12])[l * 512 + c];
        float rs[8], ks[8], vs[8], lw[8], al[8];
        const int mfirst = m0 + 8 * tg;
        float pr = bf2f(qp[0]), pk = bf2f(qp[1]), pv = bf2f(qp[2]);
#pragma unroll
        for (int i = 0; i < 8; ++i) {
            const float cr = bf2f(qr[i]), ck = bf2f(qk[i]), cv = bf2f(qv[i]);
            rs[i] = cr + (pr - cr) * mur; ks[i] = ck + (pk - ck) * muk; vs[i] = cv + (pv - cv) * muv; pr = cr; pk = ck; pv = cv;
            lw[i] = qw[i]; al[i] = bf2f(qa[i]); }
        (void)mfirst; (void)P; (void)RWD; (void)RWA;
        if (h < 7) CK_RAWLOAD(h + 1);
        float cum[8]; { float s = 0.f;
#pragma unroll
            for (int i = 0; i < 8; ++i) { s += lw[i]; cum[i] = s; }
            gsum[tg * 64 + ch] = s; }
        float kk[8];
#pragma unroll
        for (int i = 0; i < 8; ++i) { const float kv = ks[i] * kkw; const float n2 = wave_sum(kv * kv); kk[i] = kv / fmaxf(sqrtf(n2), 1e-12f); }
        __syncthreads();
        float off = 0.f, tot = 0.f;
#pragma unroll
        for (int g = 0; g < 8; ++g) { const float s = gsum[g * 64 + ch]; off += (g < tg) ? s : 0.f; tot += s; }
        if (tg == 0) WCs[ch] = __expf(tot);
        v4u wa, wb, wk, wv; unsigned ua[8], ub[8], uk[8], uv[8];
#pragma unroll
        for (int i = 0; i < 8; ++i) { const int t = 8 * tg + i; const float cu = off + cum[i];
            const float Wt = __expf(cu), Wi = __expf(-cu), Wp = __expf(cu - lw[i]), Wc = __expf(tot - cu);
            const float k2 = ks[i] * (1.0f + (al[i] - 1.0f) * kaw), bv = kk[i] * al[i];
            const unsigned at = f2bf(-kk[i] * Wp);
            CKM(CK_AT)[t * CP + ch] = (bf16)at; CKM(CK_RT)[t * CP + ch] = (bf16)f2bf(rs[i] * Wt); CKM(CK_BT)[t * CP + ch] = (bf16)f2bf(bv * Wi); CKM(CK_KT)[t * CP + ch] = (bf16)f2bf(k2 * Wi);
            ua[i] = at; ub[i] = f2bf(bv * Wc); uk[i] = f2bf(k2 * Wc); uv[i] = f2bf(vs[i]); }
        wa.x = ua[0] | (ua[1] << 16); wa.y = ua[2] | (ua[3] << 16); wa.z = ua[4] | (ua[5] << 16); wa.w = ua[6] | (ua[7] << 16);
        wb.x = ub[0] | (ub[1] << 16); wb.y = ub[2] | (ub[3] << 16); wb.z = ub[4] | (ub[5] << 16); wb.w = ub[6] | (ub[7] << 16);
        wk.x = uk[0] | (uk[1] << 16); wk.y = uk[2] | (uk[3] << 16); wk.z = uk[4] | (uk[5] << 16); wk.w = uk[6] | (uk[7] << 16);
        wv.x = uv[0] | (uv[1] << 16); wv.y = uv[2] | (uv[3] << 16); wv.z = uv[4] | (uv[5] << 16); wv.w = uv[6] | (uv[7] << 16);
        *(LAS v4u*)(CKM(CK_ATT) + ch * CP + 8 * tg) = wa; *(LAS v4u*)(CKM(CK_BHT) + ch * CP + 8 * tg) = wb; *(LAS v4u*)(CKM(CK_KHT) + ch * CP + 8 * tg) = wk; *(LAS v4u*)(CKM(CK_VT) + ch * CP + 8 * tg) = wv;
    }
    __syncthreads();
    const int w = F.wave, lane = F.lane, nt = w & 3, mtb = (w >> 2) * 2;
    const int nn = 16 * nt + (lane & 15);
#define CKF(dst, slot, row0) do { const LAS bf16* p_ = CKM(slot) + ((row0) + (lane & 15)) * CP + (lane >> 4) * 8; dst[0] = *(const LAS bf16x8*)p_; dst[1] = *(const LAS bf16x8*)(p_ + 32); } while (0)
#define CKMMA(Lf, Rf) __builtin_amdgcn_mfma_f32_16x16x32_bf16(Rf[1], Lf[1], __builtin_amdgcn_mfma_f32_16x16x32_bf16(Rf[0], Lf[0], (f32x4){0.f, 0.f, 0.f, 0.f}, 0, 0, 0), 0, 0, 0)
    const int n0 = 16 * nt, mq = 4 * (lane >> 4);
    {
        bf16x8 atn[2], btn[2], ktn[2], rtn[2], atm[2][2], btm[2][2], ktm[2][2];
        CKF(atn, CK_AT, n0); CKF(btn, CK_BT, n0); CKF(ktn, CK_KT, n0); CKF(rtn, CK_RT, n0);
#pragma unroll
        for (int mi = 0; mi < 2; ++mi) { CKF(atm[mi], CK_AT, 16 * (mtb + mi)); CKF(btm[mi], CK_BT, 16 * (mtb + mi)); CKF(ktm[mi], CK_KT, 16 * (mtb + mi)); }
        f32x4 r0[2], r1[2], r2[2], r3[2], r4[2];
#pragma unroll
        for (int mi = 0; mi < 2; ++mi) { r0[mi] = CKMMA(atn, btm[mi]); r1[mi] = CKMMA(btn, atm[mi]); r2[mi] = CKMMA(ktn, atm[mi]); r3[mi] = CKMMA(rtn, btm[mi]); r4[mi] = CKMMA(rtn, ktm[mi]); }
#pragma unroll
        for (int mi = 0; mi < 2; ++mi) { const int mm = 16 * (mtb + mi) + mq;
            f32x4 v = r0[mi];
            v.x = (mm + 0 < nn) ? v.x : 0.f; v.y = (mm + 1 < nn) ? v.y : 0.f; v.z = (mm + 2 < nn) ? v.z : 0.f; v.w = (mm + 3 < nn) ? v.w : 0.f;
            *(LAS v2u*)(CKM(CK_SET0 + 1) + nn * CP + mm) = pack4(v);
            v.x += (mm + 0 == nn) ? 1.f : 0.f; v.y += (mm + 1 == nn) ? 1.f : 0.f; v.z += (mm + 2 == nn) ? 1.f : 0.f; v.w += (mm + 3 == nn) ? 1.f : 0.f;
            *(LAS v2u*)(CKM(CK_SET0 + 2) + nn * CP + mm) = pack4(v);
            v = r1[mi];
            v.x = (nn < mm + 0) ? v.x : 0.f; v.y = (nn < mm + 1) ? v.y : 0.f; v.z = (nn < mm + 2) ? v.z : 0.f; v.w = (nn < mm + 3) ? v.w : 0.f;
            *(LAS v2u*)(CKM(CK_SET0) + nn * CP + mm) = pack4(v);
            v = r2[mi];
            v.x = (nn < mm + 0) ? v.x : 0.f; v.y = (nn < mm + 1) ? v.y : 0.f; v.z = (nn < mm + 2) ? v.z : 0.f; v.w = (nn < mm + 3) ? v.w : 0.f;
            *(LAS v2u*)(CKM(CK_AAK) + nn * CP + mm) = pack4(v);
            v = r3[mi];
            v.x = (mm + 0 <= nn) ? v.x : 0.f; v.y = (mm + 1 <= nn) ? v.y : 0.f; v.z = (mm + 2 <= nn) ? v.z : 0.f; v.w = (mm + 3 <= nn) ? v.w : 0.f;
            *(LAS v2u*)(CKM(CK_ABRT) + nn * CP + mm) = pack4(v);
            v = r4[mi];
            v.x = (mm + 0 <= nn) ? v.x : 0.f; v.y = (mm + 1 <= nn) ? v.y : 0.f; v.z = (mm + 2 <= nn) ? v.z : 0.f; v.w = (mm + 3 <= nn) ? v.w : 0.f;
            *(LAS v2u*)(CKM(CK_AKRT) + nn * CP + mm) = pack4(v); }
    }
    __syncthreads();
#pragma unroll 1
    for (int k = 0; k < 6; ++k) {
        const int sc = (k & 1) ? CK_SET1 : CK_SET0, sn = (k & 1) ? CK_SET0 : CK_SET1;
        bf16x8 bn[2], btn[2], un[2], bm[2][2], btm[2][2]; v2u uold[2];
        CKF(bn, sc, n0); CKF(btn, sc + 1, n0); CKF(un, sn + 2, n0);
#pragma unroll
        for (int mi = 0; mi < 2; ++mi) { CKF(bm[mi], sc, 16 * (mtb + mi)); CKF(btm[mi], sc + 1, 16 * (mtb + mi)); uold[mi] = *(const LAS v2u*)(CKM(sn + 2) + nn * CP + 16 * (mtb + mi) + mq); }
        f32x4 r0[2], r1[2], r2[2];
#pragma unroll
        for (int mi = 0; mi < 2; ++mi) { r0[mi] = CKMMA(bn, btm[mi]); r1[mi] = CKMMA(btn, bm[mi]); r2[mi] = CKMMA(un, bm[mi]) + unpack4(uold[mi]); }
#pragma unroll
        for (int mi = 0; mi < 2; ++mi) { const int mm = 16 * (mtb + mi) + mq;
            if (k < 5) { *(LAS v2u*)(CKM(sn) + nn * CP + mm) = pack4(r0[mi]); *(LAS v2u*)(CKM(sn + 1) + nn * CP + mm) = pack4(r1[mi]); }
            if (k > 0) *(LAS v2u*)(CKM(sc + 2) + nn * CP + mm) = pack4(r2[mi]); }
        __syncthreads();
    }
    {
        bf16x8 an[2], gn[2], um[2][2];
        CKF(an, CK_ATT, n0); CKF(gn, CK_AAK, n0);
#pragma unroll
        for (int mi = 0; mi < 2; ++mi) CKF(um[mi], CK_SET1 + 2, 16 * (mtb + mi));
        f32x4 r0[2], r1[2];
#pragma unroll
        for (int mi = 0; mi < 2; ++mi) { r0[mi] = CKMMA(an, um[mi]); r1[mi] = CKMMA(gn, um[mi]); }
#pragma unroll
        for (int mi = 0; mi < 2; ++mi) { const int mm = 16 * (mtb + mi) + mq; *(LAS v2u*)(CKM(CK_AT) + nn * CP + mm) = pack4(r0[mi]); *(LAS v2u*)(CKM(CK_KT) + nn * CP + mm) = pack4(r1[mi]); }
    }
    __syncthreads();
    {
        bf16x8 bhn[2], abn[2], ahm[2][2], gm[2][2]; v2u kh[2], rt[2], ak[2];
        CKF(bhn, CK_BHT, n0); CKF(abn, CK_ABRT, n0);
#pragma unroll
        for (int mi = 0; mi < 2; ++mi) { const int mm = 16 * (mtb + mi) + mq; CKF(ahm[mi], CK_AT, 16 * (mtb + mi)); CKF(gm[mi], CK_KT, 16 * (mtb + mi));
            kh[mi] = *(const LAS v2u*)(CKM(CK_KHT) + nn * CP + mm); rt[mi] = *(const LAS v2u*)(CKM(CK_RT) + nn * CP + mm); ak[mi] = *(const LAS v2u*)(CKM(CK_AKRT) + nn * CP + mm); }
        const float wc = WCs[nn];
        f32x4 r0[2], r1[2], r2[2], r3[2];
#pragma unroll
        for (int mi = 0; mi < 2; ++mi) { r0[mi] = CKMMA(bhn, ahm[mi]); r1[mi] = CKMMA(bhn, gm[mi]) + unpack4(kh[mi]); r2[mi] = CKMMA(abn, ahm[mi]) + unpack4(rt[mi]); r3[mi] = CKMMA(abn, gm[mi]) + unpack4(ak[mi]); }
#pragma unroll
        for (int mi = 0; mi < 2; ++mi) { const int mm = 16 * (mtb + mi) + mq;
            f32x4 v = r0[mi];
            v.x += (mm + 0 == nn) ? wc : 0.f; v.y += (mm + 1 == nn) ? wc : 0.f; v.z += (mm + 2 == nn) ? wc : 0.f; v.w += (mm + 3 == nn) ? wc : 0.f;
            { const int o_ = mm & 15; *(v2u*)(PTg + (((((nn >> 5) * 2 + (mm >> 5)) * 2 + ((mm >> 4) & 1)) * 64 + (nn & 31) + 32 * ((o_ >> 2) & 1)) * 8) + 4 * (o_ >> 3)) = pack4(v); }
            *(LAS v2u*)(CKM(CK_BT) + nn * CP + mm) = pack4(r1[mi]);
            *(v2u*)(YRm + yrt_off(tile, h, (nn >> 4) * 2 + (mm >> 5)) + ((((mm & 31) >> 3) * 16 + (nn & 15)) * 8) + (mm & 7)) = pack4(r2[mi]);
            *(LAS v2u*)(CKM(CK_AAK) + nn * CP + mm) = pack4(r3[mi]); }
    }
    __syncthreads();
    {
        bf16x8 vn_[2], yn[2], em[2][2], vm[2][2];
        CKF(vn_, CK_VT, n0); CKF(yn, CK_AAK, n0);
#pragma unroll
        for (int mi = 0; mi < 2; ++mi) { CKF(em[mi], CK_BT, 16 * (mtb + mi)); CKF(vm[mi], CK_VT, 16 * (mtb + mi)); }
        f32x4 r0[2], r1[2];
#pragma unroll
        for (int mi = 0; mi < 2; ++mi) { r0[mi] = CKMMA(vn_, em[mi]); r1[mi] = CKMMA(yn, vm[mi]); }
#pragma unroll
        for (int mi = 0; mi < 2; ++mi) { const int mm = 16 * (mtb + mi) + mq;
            *(v2u*)(QBg + ((((nn >> 5) * 2 + (mm >> 5)) * 64 + (nn & 31) + 32 * ((mm >> 2) & 1)) * 16) + 4 * ((mm & 31) >> 3)) = pack4(r0[mi]);
            *(v2u*)(YLg + ((((nn >> 4) * 4 + (mm >> 4)) * 64 + ((mm & 15) >> 2) * 16 + (nn & 15)) * 4)) = pack4(r1[mi]); }
    }
#undef CKF
#undef CKMMA
#undef CKM
}

constexpr int YTP = 520;
__device__ __forceinline__ void chunk_out_tile(Frame& F, int tile) {
    const int h = F.wave, lane = F.lane, ci = tile * 8 + h;
    const bf16* YRm = (const bf16*)(F.ws + WS_MIX); const bf16* S0g = (const bf16*)(F.ws + WS_S0) + (size_t)ci * 4096; const bf16* YLg = (const bf16*)(F.ws + WS_YL) + (size_t)ci * 4096;
    LAS bf16* yt = (LAS bf16*)F.lds;
    const int r = lane & 15, kq = lane >> 4;
    bf16x8 yb[4][2], sa[4][2]; v2u yl[4][4];
#pragma unroll
    for (int t = 0; t < 4; ++t) { yb[t][0] = *(const bf16x8*)(YRm + yrt_off(tile, h, t * 2 + 0) + lane * 8); yb[t][1] = *(const bf16x8*)(YRm + yrt_off(tile, h, t * 2 + 1) + lane * 8);
        sa[t][0] = *(const bf16x8*)(S0g + ((t * 2 + 0) * 64 + lane) * 8); sa[t][1] = *(const bf16x8*)(S0g + ((t * 2 + 1) * 64 + lane) * 8);
#pragma unroll
        for (int mt = 0; mt < 4; ++mt) yl[t][mt] = *(const v2u*)(YLg + ((t * 4 + mt) * 64 + lane) * 4); }
#pragma unroll
    for (int nt = 0; nt < 4; ++nt)
#pragma unroll
        for (int mt = 0; mt < 4; ++mt) {
            f32x4 acc = unpack4(yl[nt][mt]);
            acc = __builtin_amdgcn_mfma_f32_16x16x32_bf16(sa[mt][0], yb[nt][0], acc, 0, 0, 0); acc = __builtin_amdgcn_mfma_f32_16x16x32_bf16(sa[mt][1], yb[nt][1], acc, 0, 0, 0);
            *(LAS v2u*)(yt + (16 * nt + r) * YTP + h * 64 + 16 * mt + 4 * kq) = pack4(acc);
        }
}

__device__ __forceinline__ void rwkv_prep(Frame& F, const Args& A, int l, const XDeal xd, unsigned* c1) {
    LAS bf16* act = (LAS bf16*)F.lds;
    const bf16* P = (const bf16*)(F.ws + WS_PROJ);
    const float* mu = (const float*)A.in[5] + l * RW_IN;
    const float* w0 = (const float*)A.in[6] + l * 512; const float* a0 = (const float*)A.in[8] + l * 512;
    const bf16* WuT = (const bf16*)(F.ws + WS_LORA) + (size_t)l * LORA_L; const bf16* AuT = WuT + 512 * 64; const bf16* GuT = AuT + 512 * 64;
    float* RWD = (float*)(F.ws + WS_RWD); bf16* RWA = (bf16*)(F.ws + WS_RWA); bf16* RWG = (bf16*)(F.ws + WS_RWG);
    for (int pp_ = xd.rank; pp_ < xd.U; pp_ += xd.nloc) { const int tile = 4 * xd.rt0 + pp_;
        __syncthreads();
        const bool coh = xd_wait_proj(xd, c1, tile);
#pragma unroll 1
        for (int ib = 0; ib < 3; ++ib) {
            unsigned pc[12], pv_[12];
#pragma unroll
            for (int i = 0; i < 12; ++i) { const int e = F.tid + NTHR * (12 * ib + i), tok = e / 288, c = e % 288, m = tile * 64 + tok, col = RW_WD0 + c;
                pc[i] = P[(size_t)m * NINP + col]; pv_[i] = ((m & (SEQ - 1)) == 0) ? 0u : (coh && tok == 0) ? ld_bf16_dev(P + (size_t)(m - 1) * NINP + col) : (unsigned)P[(size_t)(m - 1) * NINP + col]; }
#pragma unroll
            for (int i = 0; i < 12; ++i) { const int e = F.tid + NTHR * (12 * ib + i), tok = e / 288, c = e % 288, col = RW_WD0 + c;
                const float p = bf2f(pc[i]), pp = bf2f(pv_[i]);
                float s = p + (pp - p) * mu[col];
                if (c < 64) s = tanhf_(s); else if (c >= 128) s = sigmoidf_(s);
                act[tok * ACTP + c] = (bf16)f2bf(s); }
        }
        __syncthreads();
        {
            const int r = F.lane & 15, kq = F.lane >> 4;
#pragma unroll 1
            for (int cp = 0; cp < 2; ++cp) {
                bf16x8 wu[2][2], au[2][2], gu[2][5];
#pragma unroll
                for (int c2 = 0; c2 < 2; ++c2) { const int ch0 = 64 * F.wave + 16 * (2 * cp + c2);
#pragma unroll
                    for (int ks = 0; ks < 2; ++ks) { wu[c2][ks] = *(const bf16x8*)(WuT + (ch0 + r) * 64 + ks * 32 + kq * 8); au[c2][ks] = *(const bf16x8*)(AuT + (ch0 + r) * 64 + ks * 32 + kq * 8); }
#pragma unroll
                    for (int ks = 0; ks < 5; ++ks) gu[c2][ks] = *(const bf16x8*)(GuT + (ch0 + r) * 160 + ks * 32 + kq * 8); }
#pragma unroll
                for (int c2 = 0; c2 < 2; ++c2) { const int ch0 = 64 * F.wave + 16 * (2 * cp + c2), chl = ch0 + 4 * kq;
                    const f32x4 w0v = *(const f32x4*)(w0 + chl), a0v = *(const f32x4*)(a0 + chl);
#pragma unroll 1
                    for (int tq = 0; tq < 4; ++tq) { const LAS bf16* ar = act + (16 * tq + r) * ACTP + kq * 8;
                        f32x4 aw = (f32x4){0.f, 0.f, 0.f, 0.f}, aa = aw, ag = aw;
#pragma unroll
                        for (int ks = 0; ks < 2; ++ks) { aw = __builtin_amdgcn_mfma_f32_16x16x32_bf16(wu[c2][ks], *(const LAS bf16x8*)(ar + ks * 32), aw, 0, 0, 0);
                            aa = __builtin_amdgcn_mfma_f32_16x16x32_bf16(au[c2][ks], *(const LAS bf16x8*)(ar + 64 + ks * 32), aa, 0, 0, 0); }
#pragma unroll
                        for (int ks = 0; ks < 5; ++ks) ag = __builtin_amdgcn_mfma_f32_16x16x32_bf16(gu[c2][ks], *(const LAS bf16x8*)(ar + 128 + ks * 32), ag, 0, 0, 0);
                        const size_t o = (size_t)(tile * 64 + 16 * tq + r) * 512 + chl;
                        f32x4 lw, av;
#pragma unroll
                        for (int jj = 0; jj < 4; ++jj) { lw[jj] = -0.6065306597126334f * sigmoidf_(w0v[jj] + aw[jj]); av[jj] = sigmoidf_(a0v[jj] + aa[jj]); }
                        *(f32x4*)(RWD + o) = lw; *(v2u*)(RWA + o) = pack4(av); *(v2u*)(RWG + o) = pack4(ag); }
                }
            }
        }
        __syncthreads();
        xd_wait(c1 + (32 + (tile >> 3)) * 64, 88u);
        { unsigned qr[8], qk[8], qv[8], qa[8], qp[3]; float qw[8];
          CK_RAWLOAD(0);
#pragma unroll 1
          for (int h = 0; h < 8; ++h) chunk_prep_item(F, A, l, tile, h, coh, qr, qk, qv, qa, qw, qp); }
    }
    __syncthreads();
}

constexpr int ACQP = 200, ACKP = 136, QRP = 100, KVP = 132;
__device__ __forceinline__ void mla_prep(Frame& F, const Args& A, int l, const XDeal xd) {
    LAS bf16* actq = (LAS bf16*)F.lds;
    LAS bf16* actkv = actq + 64 * ACQP;
    LAS float* cs = (LAS float*)(actkv + 64 * ACKP);
    LAS float* sn = cs + 64 * 16;
    LAS float* krr = sn + 64 * 16;
    LAS float* qraw = krr + 64 * 32;
    LAS float* kvraw = qraw + 64 * QRP;
    const bf16* P = (const bf16*)(F.ws + WS_PROJ);
    const int* pos = (const int*)A.in[2];
    const float* qng = (const float*)A.in[16] + l * 192; const float* kvng = (const float*)A.in[18] + l * 128;
    const float* qg = (const float*)A.in[20] + l * 96; const float* kg = (const float*)A.in[21] + l * 96;
    const bf16* WqT = (const bf16*)(F.ws + WS_MLAW) + (size_t)l * MLAW_L; const bf16* WkvT = WqT + 384 * 192;
    bf16* MQ = (bf16*)(F.ws + WS_MQ); bf16* MK = (bf16*)(F.ws + WS_MK); bf16* MV = (bf16*)(F.ws + WS_MV);
    const int tok = F.tid >> 3, s = F.tid & 7;
    for (int pp_ = xd.rank; pp_ < xd.U; pp_ += xd.nloc) { const int tile = 4 * xd.rt0 + pp_;
        const int m0 = tile * 64; const size_t m = (size_t)(m0 + tok);
        __syncthreads();
        {
            const bf16* pr = P + m * NINP;
            float q[24], kv[16]; float sq = 0.f, sk = 0.f;
#pragma unroll
            for (int i = 0; i < 3; ++i) { const v4u w = *(const v4u*)(pr + ML_CQ0 + 24 * s + 8 * i);
                q[8 * i] = bflo(w.x); q[8 * i + 1] = bfhi(w.x); q[8 * i + 2] = bflo(w.y); q[8 * i + 3] = bfhi(w.y); q[8 * i + 4] = bflo(w.z); q[8 * i + 5] = bfhi(w.z); q[8 * i + 6] = bflo(w.w); q[8 * i + 7] = bfhi(w.w); }
#pragma unroll
            for (int i = 0; i < 2; ++i) { const v4u w = *(const v4u*)(pr + ML_CKV0 + 16 * s + 8 * i);
                kv[8 * i] = bflo(w.x); kv[8 * i + 1] = bfhi(w.x); kv[8 * i + 2] = bflo(w.y); kv[8 * i + 3] = bfhi(w.y); kv[8 * i + 4] = bflo(w.z); kv[8 * i + 5] = bfhi(w.z); kv[8 * i + 6] = bflo(w.w); kv[8 * i + 7] = bfhi(w.w); }
#pragma unroll
            for (int i = 0; i < 24; ++i) sq += q[i] * q[i];
#pragma unroll
            for (int i = 0; i < 16; ++i) sk += kv[i] * kv[i];
#pragma unroll
            for (int o = 1; o < 8; o <<= 1) { sq += shx(sq, o); sk += shx(sk, o); }
            const float rq = rsqrtf(sq * (1.0f / 192.0f) + EPS), rk = rsqrtf(sk * (1.0f / 128.0f) + EPS);
#pragma unroll
            for (int i = 0; i < 3; ++i) { v4u w; const int c = 24 * s + 8 * i;
                w.x = pk2(q[8 * i] * rq * qng[c], q[8 * i + 1] * rq * qng[c + 1]); w.y = pk2(q[8 * i + 2] * rq * qng[c + 2], q[8 * i + 3] * rq * qng[c + 3]);
                w.z = pk2(q[8 * i + 4] * rq * qng[c + 4], q[8 * i + 5] * rq * qng[c + 5]); w.w = pk2(q[8 * i + 6] * rq * qng[c + 6], q[8 * i + 7] * rq * qng[c + 7]);
                *(LAS v4u*)(actq + tok * ACQP + c) = w; }
#pragma unroll
            for (int i = 0; i < 2; ++i) { v4u w; const int c = 16 * s + 8 * i;
                w.x = pk2(kv[8 * i] * rk * kvng[c], kv[8 * i + 1] * rk * kvng[c + 1]); w.y = pk2(kv[8 * i + 2] * rk * kvng[c + 2], kv[8 * i + 3] * rk * kvng[c + 3]);
                w.z = pk2(kv[8 * i + 4] * rk * kvng[c + 4], kv[8 * i + 5] * rk * kvng[c + 5]); w.w = pk2(kv[8 * i + 6] * rk * kvng[c + 6], kv[8 * i + 7] * rk * kvng[c + 7]);
                *(LAS v4u*)(actkv + tok * ACKP + c) = w; }
            const v2u kw = *(const v2u*)(pr + ML_KR0 + 4 * s);
            const float kx[4] = {bflo(kw.x), bfhi(kw.x), bflo(kw.y), bfhi(kw.y)};
            const float pf = (float)pos[m];
#pragma unroll
            for (int j = 0; j < 4; ++j) { const int i = (4 * s + j) & 15; const float inv = exp2f(-(float)i * (13.287712379549449f / 16.0f));
                const float ang = pf * inv, c = cosf(ang), sv = sinf(ang);
                const float other = shx(kx[j], 4);
                krr[tok * 32 + 4 * s + j] = (s < 4) ? (kx[j] * c - other * sv) : (kx[j] * c + other * sv);
                if (s < 4) { cs[tok * 16 + i] = c; sn[tok * 16 + i] = sv; } }
        }
        __syncthreads();
        const int r = F.lane & 15, kq = F.lane >> 4, tq = F.wave & 3, hf = F.wave >> 2;
        bf16x8 wq[3][6], wkv[4][4];
#define ML_LOADW(h_) do { _Pragma("unroll") for (int ct_ = 0; ct_ < 3; ++ct_) _Pragma("unroll") for (int ks_ = 0; ks_ < 6; ++ks_) wq[ct_][ks_] = *(const bf16x8*)(WqT + (size_t)((h_) * 96 + 16 * (3 * hf + ct_) + r) * 192 + ks_ * 32 + kq * 8); } while (0)
#define ML_LOADKV(h_) do { _Pragma("unroll") for (int ct_ = 0; ct_ < 4; ++ct_) _Pragma("unroll") for (int ks_ = 0; ks_ < 4; ++ks_) wkv[ct_][ks_] = *(const bf16x8*)(WkvT + (size_t)((h_) * 128 + 16 * (4 * hf + ct_) + r) * 128 + ks_ * 32 + kq * 8); } while (0)
        ML_LOADW(0);
#pragma unroll 1
        for (int h = 0; h < 4; ++h) {
            {
                const LAS bf16* aq = actq + (16 * tq + r) * ACQP + kq * 8; const LAS bf16* akv = actkv + (16 * tq + r) * ACKP + kq * 8;
                ML_LOADKV(h);
                { bf16x8 fa[6];
#pragma unroll
                  for (int ks = 0; ks < 6; ++ks) fa[ks] = *(const LAS bf16x8*)(aq + ks * 32);
#pragma unroll
                  for (int ct = 0; ct < 3; ++ct) { const int d0 = 16 * (3 * hf + ct);
                      f32x4 acc = (f32x4){0.f, 0.f, 0.f, 0.f};
#pragma unroll
                      for (int ks = 0; ks < 6; ++ks) acc = __builtin_amdgcn_mfma_f32_16x16x32_bf16(wq[ct][ks], fa[ks], acc, 0, 0, 0);
                      *(LAS f32x4*)(qraw + (16 * tq + r) * QRP + d0 + 4 * kq) = acc; } }
                { bf16x8 fk[4];
#pragma unroll
                  for (int ks = 0; ks < 4; ++ks) fk[ks] = *(const LAS bf16x8*)(akv + ks * 32);
#pragma unroll
                  for (int ct = 0; ct < 4; ++ct) { const int e0 = 16 * (4 * hf + ct);
                      f32x4 acc = (f32x4){0.f, 0.f, 0.f, 0.f};
#pragma unroll
                      for (int ks = 0; ks < 4; ++ks) acc = __builtin_amdgcn_mfma_f32_16x16x32_bf16(wkv[ct][ks], fk[ks], acc, 0, 0, 0);
                      *(LAS f32x4*)(kvraw + (16 * tq + r) * KVP + e0 + 4 * kq) = acc; } }
                if (h < 3) ML_LOADW(h + 1);
            }
            __syncthreads();
            {
                float qv[12], kv[12]; float sq = 0.f, sk = 0.f;
#pragma unroll
                for (int dd = 0; dd < 12; ++dd) { const int d = 12 * s + dd;
                    float q = qraw[tok * QRP + d], k;
                    if (d >= 64) { const int rr = d - 64, i = rr & 15; const float c = cs[tok * 16 + i], sv = sn[tok * 16 + i];
                        q = (rr < 16) ? (q * c - qraw[tok * QRP + d + 16] * sv) : (q * c + qraw[tok * QRP + d - 16] * sv);
                        k = krr[tok * 32 + rr];
                    } else k = kvraw[tok * KVP + d];
                    qv[dd] = q; kv[dd] = k; sq += q * q; sk += k * k; }
#pragma unroll
                for (int o = 1; o < 8; o <<= 1) { sq += shx(sq, o); sk += shx(sk, o); }
                const float rq = rsqrtf(sq * (1.0f / 96.0f) + EPS) * 0.14724445052402816f, rk = rsqrtf(sk * (1.0f / 96.0f) + EPS);
#pragma unroll
                for (int g = 0; g < 3; ++g) { const int d = 12 * s + 4 * g; v2u wq, wk;
                    wq.x = pk2(qv[4 * g] * rq * qg[d], qv[4 * g + 1] * rq * qg[d + 1]); wq.y = pk2(qv[4 * g + 2] * rq * qg[d + 2], qv[4 * g + 3] * rq * qg[d + 3]);
                    wk.x = pk2(kv[4 * g] * rk * kg[d], kv[4 * g + 1] * rk * kg[d + 1]); wk.y = pk2(kv[4 * g + 2] * rk * kg[d + 2], kv[4 * g + 3] * rk * kg[d + 3]);
                    *(v2u*)(MQ + m * 384 + h * 96 + d) = wq; *(v2u*)(MK + m * 384 + h * 96 + d) = wk; }
                { const int dv = F.tid >> 3, t8 = 8 * (F.tid & 7); v4u w;
                  w.x = pk2(kvraw[(t8 + 0) * KVP + 64 + dv], kvraw[(t8 + 1) * KVP + 64 + dv]); w.y = pk2(kvraw[(t8 + 2) * KVP + 64 + dv], kvraw[(t8 + 3) * KVP + 64 + dv]);
                  w.z = pk2(kvraw[(t8 + 4) * KVP + 64 + dv], kvraw[(t8 + 5) * KVP + 64 + dv]); w.w = pk2(kvraw[(t8 + 6) * KVP + 64 + dv], kvraw[(t8 + 7) * KVP + 64 + dv]);
                  bf16* vrow = MV + ((size_t)(((m0 >> 13) * 4 + h) * 64 + dv) << 13) + (m0 & (SEQ - 1)) + (t8 & ~15);
                  *(v2u*)(vrow + ((t8 & 8) ? 4 : 0)) = (v2u){w.x, w.y}; *(v2u*)(vrow + ((t8 & 8) ? 12 : 8)) = (v2u){w.z, w.w}; }
            }
            __syncthreads();
        }
    }
    __syncthreads();
#undef ML_LOADW
#undef ML_LOADKV
}

constexpr int GVP = 136, GUP = 72;
__device__ __forceinline__ void gmlp_stage(Frame& F, const Args& A, int l, const XDeal xd) {
    LAS bf16* vnT = (LAS bf16*)F.lds;
    LAS bf16* ug = vnT + 64 * GVP;
    const bf16* P = (const bf16*)(F.ws + WS_PROJ); bf16* MIXp = (bf16*)(F.ws + WS_MIX);
    const float* vg = (const float*)A.in[22] + l * 256; const float* gb = (const float*)A.in[24] + l * 4 * 128;
    const int t = F.tid >> 2, dq = F.tid & 3;
    v4u v0, v1, u0, u1;
#define GM_RAWLOAD(item_) do { const int g_ = (item_) & 3; const size_t m_ = (size_t)((item_) >> 2) * 128 + t; \
        v0 = *(const v4u*)(P + m_ * NINP + GM_V0 + g_ * 64 + 16 * dq); v1 = *(const v4u*)(P + m_ * NINP + GM_V0 + g_ * 64 + 16 * dq + 8); \
        u0 = *(const v4u*)(P + m_ * NINP + GM_U0 + g_ * 64 + 16 * dq); u1 = *(const v4u*)(P + m_ * NINP + GM_U0 + g_ * 64 + 16 * dq + 8); } while (0)
    const int nit = 2 * ((xd.U - xd.rank + xd.nloc - 1) / xd.nloc);
#define GM_ITEM(k_) (8 * xd.rt0 + 2 * (xd.rank + ((k_) >> 1) * xd.nloc) + ((k_) & 1))
    if (nit > 0) GM_RAWLOAD(GM_ITEM(0));
    for (int k = 0; k < nit; ++k) { const int item = GM_ITEM(k);
        const int g = item & 3, ch = item >> 2;
        const bf16* WS = (const bf16*)(F.ws + WS_GWS) + (size_t)(l * 4 + g) * 16384;
        bf16x8 lf[4];
#pragma unroll
        for (int ks = 0; ks < 4; ++ks) lf[ks] = *(const bf16x8*)(WS + (16 * F.wave + (F.lane & 15)) * 128 + ks * 32 + (F.lane >> 4) * 8);
        const float bias = gb[g * 128 + 16 * F.wave + (F.lane & 15)];
        __syncthreads();
        {
            float z[16], uu[16]; float ss = 0.f;
            const unsigned vw[8] = {v0.x, v0.y, v0.z, v0.w, v1.x, v1.y, v1.z, v1.w}, uw[8] = {u0.x, u0.y, u0.z, u0.w, u1.x, u1.y, u1.z, u1.w};
#pragma unroll
            for (int i = 0; i < 8; ++i) { z[2 * i] = gelu_tanh(bflo(vw[i])); z[2 * i + 1] = gelu_tanh(bfhi(vw[i])); uu[2 * i] = gelu_tanh(bflo(uw[i])); uu[2 * i + 1] = gelu_tanh(bfhi(uw[i])); ss += z[2 * i] * z[2 * i] + z[2 * i + 1] * z[2 * i + 1]; }
            if (k + 1 < nit) GM_RAWLOAD(GM_ITEM(k + 1));
            ss += shx(ss, 1); ss += shx(ss, 2);
            const float rstd = rsqrtf(ss * (1.0f / 64.0f) + EPS);
#pragma unroll
            for (int i = 0; i < 16; ++i) vnT[(16 * dq + i) * GVP + t] = (bf16)f2bf(z[i] * rstd * vg[g * 64 + 16 * dq + i]);
            v4u w0, w1; w0.x = pk2(uu[0], uu[1]); w0.y = pk2(uu[2], uu[3]); w0.z = pk2(uu[4], uu[5]); w0.w = pk2(uu[6], uu[7]); w1.x = pk2(uu[8], uu[9]); w1.y = pk2(uu[10], uu[11]); w1.z = pk2(uu[12], uu[13]); w1.w = pk2(uu[14], uu[15]);
            *(LAS v4u*)(ug + t * GUP + 16 * dq) = w0; *(LAS v4u*)(ug + t * GUP + 16 * dq + 8) = w1;
        }
        __syncthreads();
        {
            const int r = F.lane & 15, kq = F.lane >> 4, tt = F.wave;
            const int nks = (16 * tt + 15) / 32 + 1;
            f32x4 acc[4];
#pragma unroll
            for (int dt = 0; dt < 4; ++dt) acc[dt] = (f32x4){0.f, 0.f, 0.f, 0.f};
#pragma unroll
            for (int ks = 0; ks < 4; ++ks) if (ks < nks) {
#pragma unroll
                for (int dt = 0; dt < 4; ++dt) acc[dt] = __builtin_amdgcn_mfma_f32_16x16x32_bf16(*(const LAS bf16x8*)(vnT + (16 * dt + r) * GVP + ks * 32 + kq * 8), lf[ks], acc[dt], 0, 0, 0); }
            const int tl = 16 * tt + r;
#pragma unroll
            for (int dt = 0; dt < 4; ++dt) { const f32x4 uv = unpack4(*(const LAS v2u*)(ug + tl * GUP + 16 * dt + 4 * kq));
                *(v2u*)(MIXp + ((size_t)ch * 128 + tl) * 1024 + MIX_GM0 + g * 64 + 16 * dt + 4 * kq) = pack4(uv * (acc[dt] + bias)); }
        }
    }
#undef GM_RAWLOAD
#undef GM_ITEM
    __syncthreads();
}

typedef float f32x16 __attribute__((ext_vector_type(16)));
struct ScanOps { v4u pt[2][2][2]; v4u qb[2][2]; };
__device__ __forceinline__ void scan_load(ScanOps& o, const GAS bf16* PTc, const GAS bf16* QBc, int lane, int vh) {
#pragma unroll
    for (int kb2 = 0; kb2 < 2; ++kb2) {
#pragma unroll
        for (int kb1 = 0; kb1 < 2; ++kb1)
#pragma unroll
            for (int s = 0; s < 2; ++s) o.pt[kb2][kb1][s] = *(const GAS v4u*)(PTc + ((((kb2 * 2 + kb1) * 2 + s) * 64 + lane) * 8));
        const GAS bf16* q = QBc + (((vh * 2 + kb2) * 64 + lane) * 16);
        o.qb[kb2][0] = *(const GAS v4u*)q; o.qb[kb2][1] = *(const GAS v4u*)(q + 8); }
}
__device__ __forceinline__ void scan_step(f32x16 (&acc)[2], const ScanOps& cur, ScanOps& nxt, bool more, const GAS bf16* PTn, const GAS bf16* QBn, GAS bf16* S0c, int lane, int vh) {
    const int hh = lane >> 5, vv = 32 * vh + (lane & 31);
    bf16x8 bfr[2][2];
#pragma unroll
    for (int kb = 0; kb < 2; ++kb) {
#pragma unroll
        for (int g = 0; g < 4; ++g) { v2u w; w.x = pk2(acc[kb][4 * g], acc[kb][4 * g + 1]); w.y = pk2(acc[kb][4 * g + 2], acc[kb][4 * g + 3]);
            *(GAS v2u*)(S0c + ((((vv >> 4) * 2 + kb) * 64 + g * 16 + (vv & 15)) * 8) + 4 * hh) = w;
            const int s = g >> 1, o = (g & 1) * 4;
            bfr[kb][s][o] = (short)(w.x & 0xffffu); bfr[kb][s][o + 1] = (short)(w.x >> 16); bfr[kb][s][o + 2] = (short)(w.y & 0xffffu); bfr[kb][s][o + 3] = (short)(w.y >> 16); } }
    if (more) scan_load(nxt, PTn, QBn, lane, vh);
#pragma unroll
    for (int kb2 = 0; kb2 < 2; ++kb2) {
        f32x16 nacc;
        { const v4u q0 = cur.qb[kb2][0], q1 = cur.qb[kb2][1];
          nacc[0] = bflo(q0.x); nacc[1] = bfhi(q0.x); nacc[2] = bflo(q0.y); nacc[3] = bfhi(q0.y); nacc[4] = bflo(q0.z); nacc[5] = bfhi(q0.z); nacc[6] = bflo(q0.w); nacc[7] = bfhi(q0.w);
          nacc[8] = bflo(q1.x); nacc[9] = bfhi(q1.x); nacc[10] = bflo(q1.y); nacc[11] = bfhi(q1.y); nacc[12] = bflo(q1.z); nacc[13] = bfhi(q1.z); nacc[14] = bflo(q1.w); nacc[15] = bfhi(q1.w); }
#pragma unroll
        for (int kb1 = 0; kb1 < 2; ++kb1)
#pragma unroll
            for (int s = 0; s < 2; ++s) { const bf16x8 a = __builtin_bit_cast(bf16x8, cur.pt[kb2][kb1][s]);
                nacc = __builtin_amdgcn_mfma_f32_32x32x16_bf16(a, bfr[kb1][s], nacc, 0, 0, 0); }
        acc[kb2] = nacc;
    }
}
__device__ __forceinline__ void rwkv_state_scan(Frame& F) {
    if (F.bid >= 16 || F.wave >= 2) return;
    const int gw = F.bid * 2 + F.wave, bh = gw >> 1, vh = gw & 1, b = bh >> 3, h = bh & 7;
    const int lane = F.lane;
    const GAS bf16* PTb = (const GAS bf16*)(F.ws + WS_PT) + (size_t)((b * 128) * 8 + h) * 4096; const GAS bf16* QBb = (const GAS bf16*)(F.ws + WS_QB) + (size_t)((b * 128) * 8 + h) * 4096;
    GAS bf16* S0b = (GAS bf16*)(F.ws + WS_S0) + (size_t)((b * 128) * 8 + h) * 4096;
    f32x16 acc[2];
#pragma unroll
    for (int kb = 0; kb < 2; ++kb)
#pragma unroll
        for (int i = 0; i < 16; ++i) acc[kb][i] = 0.f;
    ScanOps o0, o1;
    scan_load(o0, PTb, QBb, lane, vh);
    constexpr size_t CS = 8 * 4096;
#pragma unroll 1
    for (int c = 0; c < 128; c += 2) {
        scan_step(acc, o0, o1, true, PTb + (size_t)(c + 1) * CS, QBb + (size_t)(c + 1) * CS, S0b + (size_t)c * CS, lane, vh);
        scan_step(acc, o1, o0, c + 2 < 128, PTb + (size_t)(c + 2) * CS, QBb + (size_t)(c + 2) * CS, S0b + (size_t)(c + 1) * CS, lane, vh);
    }
}

constexpr int AKP = 104, AVP = 72;
constexpr int ABUF = 64 * AKP * 2 + 64 * AVP * 2;
__device__ __forceinline__ void attn_tile(const LAS bf16* Kb, const bf16x8 (&qf)[6], f32x16 (&o)[2], float& lrun, int key0, int qmin, int qpos, int ql, int hh) {
    const LAS bf16* Vb = Kb + 64 * AKP;
    if (key0 > qmin + 31) return;
    f32x16 st[2];
#pragma unroll
    for (int sub = 0; sub < 2; ++sub) {
#pragma unroll
        for (int i = 0; i < 16; ++i) st[sub][i] = 0.f;
#pragma unroll
        for (int s = 0; s < 6; ++s) { const bf16x8 a = *(const LAS bf16x8*)(Kb + (32 * sub + ql) * AKP + 16 * s + 8 * hh); st[sub] = __builtin_amdgcn_mfma_f32_32x32x16_bf16(a, qf[s], st[sub], 0, 0, 0); }
    }
    if (key0 + 63 > qmin) {
#pragma unroll
        for (int sub = 0; sub < 2; ++sub)
#pragma unroll
            for (int i = 0; i < 16; ++i) { const int key = key0 + 32 * sub + (i & 3) + 8 * (i >> 2) + 4 * hh; st[sub][i] = (key > qpos) ? -1.0e30f : st[sub][i]; }
    }
    float ps = 0.f;
#pragma unroll
    for (int sub = 0; sub < 2; ++sub)
#pragma unroll
        for (int i = 0; i < 16; ++i) { const float p = __builtin_amdgcn_exp2f(fminf(st[sub][i], 100.0f)); st[sub][i] = p; ps += p; }
    lrun += ps;
    bf16x8 pf[2][2];
#pragma unroll
    for (int sub = 0; sub < 2; ++sub)
#pragma unroll
        for (int s2 = 0; s2 < 2; ++s2) { v4u pw; pw.x = pk2(st[sub][8 * s2], st[sub][8 * s2 + 1]); pw.y = pk2(st[sub][8 * s2 + 2], st[sub][8 * s2 + 3]); pw.z = pk2(st[sub][8 * s2 + 4], st[sub][8 * s2 + 5]); pw.w = pk2(st[sub][8 * s2 + 6], st[sub][8 * s2 + 7]);
            pf[sub][s2] = __builtin_bit_cast(bf16x8, pw); }
#pragma unroll
    for (int mt = 0; mt < 2; ++mt)
#pragma unroll
        for (int sub = 0; sub < 2; ++sub)
#pragma unroll
            for (int s2 = 0; s2 < 2; ++s2)
                o[mt] = __builtin_amdgcn_mfma_f32_32x32x16_bf16(*(const LAS bf16x8*)(Vb + (32 * mt + ql) * AVP + 32 * sub + 16 * s2 + 8 * hh), pf[sub][s2], o[mt], 0, 0, 0);
}
struct AttnStage { v4u k0, k1, v, k2, k3, w; };
constexpr int ATT_PER_BH = 2112, ATT_TOTAL = 8 * ATT_PER_BH, ATT_LS = 8, ATT_LN = 72, ATT_NS = 16;
constexpr size_t WS_PART = WS_RWD;
constexpr int PART_SZ = 256 * 64 * 2 + 256 * 8;
static_assert((size_t)512 * PART_SZ <= (size_t)32 * MiB, "partials fit the dead decay buffer");
__device__ __forceinline__ int att_vb(int c) { return ((c & 7) << 5) | (c >> 3); }
__device__ __forceinline__ int att_start(int vb) { const int x = vb >> 5, j = vb & 31; int loc = (j < 2) ? ATT_LS * j : 2 * ATT_LS + ATT_LN * (j - 2); loc = loc < ATT_PER_BH ? loc : ATT_PER_BH; return x * ATT_PER_BH + loc; }
__device__ __forceinline__ int att_blockof(int g) { const int x = g / ATT_PER_BH, loc = g % ATT_PER_BH; return x * 32 + ((loc < 2 * ATT_LS) ? loc / ATT_LS : 2 + (loc - 2 * ATT_LS) / ATT_LN); }
__device__ __forceinline__ void attn_piece(Frame& F, int b, int h, int qb, int kt0, int kt1, unsigned char* part) {
    const bf16* MQ = (const bf16*)(F.ws + WS_MQ); const bf16* MK = (const bf16*)(F.ws + WS_MK); const bf16* MVT = (const bf16*)(F.ws + WS_MV);
    bf16* MIXp = (bf16*)(F.ws + WS_MIX);
    const int lane = F.lane, w = F.wave, hh = lane >> 5, ql = lane & 31;
    const int qmin = qb * 256 + 32 * w, qpos = qmin + ql;
    const size_t m = (size_t)b * SEQ + qpos;
    bf16x8 qf[6];
#pragma unroll
    for (int s = 0; s < 6; ++s) qf[s] = *(const bf16x8*)(MQ + m * 384 + h * 96 + 16 * s + 8 * hh);
    f32x16 o[2];
#pragma unroll
    for (int i = 0; i < 16; ++i) { o[0][i] = 0.f; o[1][i] = 0.f; }
    float lrun = 0.f;
    const int kr0 = F.tid / 12, kc0 = F.tid % 12, kr1 = (F.tid + 512) / 12, kc1 = (F.tid + 512) % 12, vr = F.tid >> 3, vc = F.tid & 7;
    const bf16* kg = MK + (size_t)b * SEQ * 384 + h * 96; const bf16* vg = MVT + ((size_t)((b * 4 + h) * 64 + vr) << 13) + 8 * vc;
    const bool two = F.tid < 256;
#define ATT_LOAD(R, kt_) do { const size_t ko_ = (size_t)(kt_) * 64; R.k0 = *(const v4u*)(kg + (ko_ + kr0) * 384 + 8 * kc0); if (two) R.k1 = *(const v4u*)(kg + (ko_ + kr1) * 384 + 8 * kc1); R.v = *(const v4u*)(vg + ko_); \
        R.k2 = *(const v4u*)(kg + (ko_ + 64 + kr0) * 384 + 8 * kc0); if (two) R.k3 = *(const v4u*)(kg + (ko_ + 64 + kr1) * 384 + 8 * kc1); R.w = *(const v4u*)(vg + ko_ + 64); } while (0)
#define ATT_WRITE(R, slot_) do { LAS unsigned char* B_ = F.lds + (slot_) * 2 * ABUF; *(LAS v4u*)(B_ + (kr0 * AKP + 8 * kc0) * 2) = R.k0; if (two) *(LAS v4u*)(B_ + (kr1 * AKP + 8 * kc1) * 2) = R.k1; *(LAS v4u*)(B_ + 64 * AKP * 2 + (vr * AVP + 8 * vc) * 2) = R.v; \
        *(LAS v4u*)(B_ + ABUF + (kr0 * AKP + 8 * kc0) * 2) = R.k2; if (two) *(LAS v4u*)(B_ + ABUF + (kr1 * AKP + 8 * kc1) * 2) = R.k3; *(LAS v4u*)(B_ + ABUF + 64 * AKP * 2 + (vr * AVP + 8 * vc) * 2) = R.w; } while (0)
    AttnStage RA, RB; RA.k1 = (v4u){0u, 0u, 0u, 0u}; RA.k3 = RA.k1; RB.k1 = RA.k1; RB.k3 = RA.k1;
    __syncthreads();
    ATT_LOAD(RA, kt0); ATT_LOAD(RB, kt0 + 2);
    ATT_WRITE(RA, 0);
    __syncthreads();
#pragma unroll 1
    for (int kt = kt0; kt < kt1; kt += 4) {
        if (kt + 4 < kt1) ATT_LOAD(RA, kt + 4);
        attn_tile((const LAS bf16*)F.lds, qf, o, lrun, kt * 64, qmin, qpos, ql, hh);
        attn_tile((const LAS bf16*)(F.lds + ABUF), qf, o, lrun, (kt + 1) * 64, qmin, qpos, ql, hh);
        ATT_WRITE(RB, 1);
        __syncthreads();
        if (kt + 6 < kt1) ATT_LOAD(RB, kt + 6);
        attn_tile((const LAS bf16*)(F.lds + 2 * ABUF), qf, o, lrun, (kt + 2) * 64, qmin, qpos, ql, hh);
        attn_tile((const LAS bf16*)(F.lds + 3 * ABUF), qf, o, lrun, (kt + 3) * 64, qmin, qpos, ql, hh);
        if (kt + 4 < kt1) ATT_WRITE(RA, 0);
        __syncthreads();
    }
#undef ATT_LOAD
#undef ATT_WRITE
    const float lt = lrun + shx(lrun, 32);
    if (part == nullptr) { const float il = 1.0f / lt;
#pragma unroll
        for (int mt = 0; mt < 2; ++mt)
#pragma unroll
            for (int g = 0; g < 4; ++g) { v2u wv; wv.x = pk2(o[mt][4 * g] * il, o[mt][4 * g + 1] * il); wv.y = pk2(o[mt][4 * g + 2] * il, o[mt][4 * g + 3] * il);
                *(v2u*)(MIXp + m * 1024 + MIX_MLA0 + h * 64 + 32 * mt + 8 * g + 4 * hh) = wv; }
    } else { bf16* po = (bf16*)part; float* pml = (float*)(part + 256 * 64 * 2); const int row = 32 * w + ql;
#pragma unroll
        for (int mt = 0; mt < 2; ++mt)
#pragma unroll
            for (int g = 0; g < 4; ++g) { v2u wv; wv.x = pk2(o[mt][4 * g], o[mt][4 * g + 1]); wv.y = pk2(o[mt][4 * g + 2], o[mt][4 * g + 3]);
                *(v2u*)(po + row * 64 + 32 * mt + 8 * g + 4 * hh) = wv; }
        if (hh == 0) { pml[2 * row] = 0.f; pml[2 * row + 1] = lt; }
    }
}
__device__ __forceinline__ void attn_mfma(Frame& F) {
    const int vb = att_vb(F.bid); int g = att_start(vb); const int gend = att_start(vb + 1); int k = 0;
    while (g < gend) {
        const int bh = g / ATT_PER_BH, r = g % ATT_PER_BH;
        int x = 0; while (2 * (x + 1) * (x + 2) <= r) ++x;
        const int kt0 = r - 2 * x * (x + 1), n = 4 * (x + 1);
        const int kt1 = (kt0 + (gend - g) < n) ? kt0 + (gend - g) : n;
        const bool whole = (kt0 == 0 && kt1 == n);
        attn_piece(F, bh >> 2, bh & 3, x, kt0, kt1, whole ? nullptr : (unsigned char*)(F.ws + WS_PART) + (size_t)(vb * 2 + (k == 0 ? 0 : 1)) * PART_SZ);
        g += kt1 - kt0; ++k;
    }
    __syncthreads();
}
__device__ __forceinline__ void attn_merge(Frame& F, const XDeal xd) {
    bf16* MIXp = (bf16*)(F.ws + WS_MIX);
    for (int pp = xd.rank; pp < xd.U; pp += xd.nloc) { const int R_ = xd.rt0 + (pp >> 2);
        const int bh = (R_ >> 5) * 4 + (pp & 3), x = R_ & 31, a = bh * ATT_PER_BH + 2 * x * (x + 1), bnd = a + 4 * (x + 1);
        const int c0 = att_blockof(a), c1 = att_blockof(bnd - 1);
        if (c0 == c1 && att_start(c0) <= a && bnd <= att_start(c0 + 1)) continue;
        const int row = F.tid >> 1, hf = F.tid & 1;
        float acc[32]; float lsum = 0.f;
#pragma unroll
        for (int i = 0; i < 32; ++i) acc[i] = 0.f;
        for (int c = c0; c <= c1; ++c) { const int slot = c * 2 + ((att_start(c) >= a) ? 0 : 1);
            const unsigned char* pp = (const unsigned char*)(F.ws + WS_PART) + (size_t)slot * PART_SZ; const float* pml = (const float*)(pp + 256 * 64 * 2);
            const float sc = 1.0f; lsum += pml[2 * row + 1];
            const bf16* po = (const bf16*)pp + row * 64 + 32 * hf;
#pragma unroll
            for (int q = 0; q < 4; ++q) { const v4u wv = *(const v4u*)(po + 8 * q);
                acc[8 * q] += bflo(wv.x) * sc; acc[8 * q + 1] += bfhi(wv.x) * sc; acc[8 * q + 2] += bflo(wv.y) * sc; acc[8 * q + 3] += bfhi(wv.y) * sc;
                acc[8 * q + 4] += bflo(wv.z) * sc; acc[8 * q + 5] += bfhi(wv.z) * sc; acc[8 * q + 6] += bflo(wv.w) * sc; acc[8 * q + 7] += bfhi(wv.w) * sc; } }
        const float il = 1.0f / lsum;
        const size_t m = (size_t)(bh >> 2) * SEQ + x * 256 + row;
#pragma unroll
        for (int q = 0; q < 4; ++q) { v4u wv; wv.x = pk2(acc[8 * q] * il, acc[8 * q + 1] * il); wv.y = pk2(acc[8 * q + 2] * il, acc[8 * q + 3] * il); wv.z = pk2(acc[8 * q + 4] * il, acc[8 * q + 5] * il); wv.w = pk2(acc[8 * q + 6] * il, acc[8 * q + 7] * il);
            *(v4u*)(MIXp + m * 1024 + MIX_MLA0 + (bh & 3) * 64 + 32 * hf + 8 * q) = wv; }
    }
}

__device__ __forceinline__ void rwkv_out(Frame& F, const Args& A, int l, const XDeal xd, unsigned* cd) {
    const bf16* P = (const bf16*)(F.ws + WS_PROJ); bf16* MIX = (bf16*)(F.ws + WS_MIX);
    const bf16* RWA = (const bf16*)(F.ws + WS_RWA); const bf16* RWG = (const bf16*)(F.ws + WS_RWG);
    const float* mu = (const float*)A.in[5] + l * RW_IN;
    const int c0 = F.lane * 8;
    const float* ka = (const float*)A.in[12] + l * 512 + c0; const float* rk = (const float*)A.in[13] + l * 512 + c0;
    const float* lg = (const float*)A.in[14] + l * 512 + c0; const float* lb = (const float*)A.in[15] + l * 512 + c0;
    for (int pp = xd.rank; pp < xd.U; pp += xd.nloc) { const int tile = 4 * xd.rt0 + pp;
      __syncthreads();
      chunk_out_tile(F, tile);
      __syncthreads();
      for (int ti = 0; ti < 8; ++ti) { const int m = tile * 64 + F.wave * 8 + ti;
        const bool first = (m & (SEQ - 1)) == 0;
        float y[8], r[8], k[8], v[8], a[8], g[8];
        const v4u yy = *(const LAS v4u*)((const LAS bf16*)F.lds + (F.wave * 8 + ti) * YTP + c0), aa = *(const v4u*)(RWA + (size_t)m * 512 + c0), gg = *(const v4u*)(RWG + (size_t)m * 512 + c0);
        const unsigned yw[4] = {yy.x, yy.y, yy.z, yy.w}, aw[4] = {aa.x, aa.y, aa.z, aa.w}, gw4[4] = {gg.x, gg.y, gg.z, gg.w};
#pragma unroll
        for (int i = 0; i < 4; ++i) { y[2 * i] = bflo(yw[i]); y[2 * i + 1] = bfhi(yw[i]); a[2 * i] = bflo(aw[i]); a[2 * i + 1] = bfhi(aw[i]); g[2 * i] = bflo(gw4[i]); g[2 * i + 1] = bfhi(gw4[i]); }
#pragma unroll
        for (int s = 0; s < 3; ++s) { const int col = (s == 0 ? RW_R0 : s == 1 ? RW_K0 : RW_V0) + c0;
            const v4u c4 = *(const v4u*)(P + (size_t)m * NINP + col); v4u p4 = (v4u){0u, 0u, 0u, 0u}; if (!first) p4 = *(const v4u*)(P + (size_t)(m - 1) * NINP + col);
            const unsigned cw[4] = {c4.x, c4.y, c4.z, c4.w}, pw[4] = {p4.x, p4.y, p4.z, p4.w};
#pragma unroll
            for (int i = 0; i < 8; ++i) { const float cv = (i & 1) ? bfhi(cw[i >> 1]) : bflo(cw[i >> 1]), pvv = (i & 1) ? bfhi(pw[i >> 1]) : bflo(pw[i >> 1]);
                const float sv = cv + (pvv - cv) * mu[col + i]; if (s == 0) r[i] = sv; else if (s == 1) k[i] = sv; else v[i] = sv; } }
        float sm = 0.f, bon = 0.f;
#pragma unroll
        for (int i = 0; i < 8; ++i) { sm += y[i]; const float k2 = k[i] * (1.0f + (a[i] - 1.0f) * ka[i]); bon += r[i] * k2 * rk[i]; }
#pragma unroll
        for (int o = 1; o < 8; o <<= 1) { sm += shx(sm, o); bon += shx(bon, o); }
        const float mean = sm * (1.0f / 64.0f); float vr = 0.f;
#pragma unroll
        for (int i = 0; i < 8; ++i) { const float d = y[i] - mean; vr += d * d; }
#pragma unroll
        for (int o = 1; o < 8; o <<= 1) vr += shx(vr, o);
        const float rstd = rsqrtf(vr * (1.0f / 64.0f) + GN_EPS);
        float ov[8];
#pragma unroll
        for (int i = 0; i < 8; ++i) ov[i] = ((y[i] - mean) * rstd * lg[i] + lb[i] + bon * v[i]) * g[i];
        v4u o4; o4.x = pk2(ov[0], ov[1]); o4.y = pk2(ov[2], ov[3]); o4.z = pk2(ov[4], ov[5]); o4.w = pk2(ov[6], ov[7]);
        *(v4u*)(MIX + (size_t)m * 1024 + c0) = o4;
      }
      xd_signal(cd + (tile >> 2) * 64);
    }
}

constexpr size_t WS_MKF = WS_MN, WS_MVF = WS_MN + 256 * 1024;
__device__ __forceinline__ void memkv_arrange(Frame& F, const Args& A) {
    if (F.bid < 16 || F.bid >= 24) return;
    const int bh = F.bid - 16, b = bh >> 2, h = bh & 3;
    const float* MKV = (const float*)(F.ws + WS_MKV); const float* kg = (const float*)A.in[28];
    bf16* KF = (bf16*)(F.ws + WS_MKF) + (size_t)bh * 16384; bf16* VF = (bf16*)(F.ws + WS_MVF) + (size_t)bh * 16384;
    { const int key = F.tid >> 1, hf = F.tid & 1;
      const float* kp = MKV + (size_t)(b * 256 + key) * 512 + h * 64 + 32 * hf;
      float kv[32]; float ss = 0.f;
#pragma unroll
      for (int i = 0; i < 8; ++i) { const f32x4 x = *(const f32x4*)(kp + 4 * i); kv[4 * i] = x.x; kv[4 * i + 1] = x.y; kv[4 * i + 2] = x.z; kv[4 * i + 3] = x.w; ss += (x.x * x.x + x.y * x.y) + (x.z * x.z + x.w * x.w); }
      ss += shx(ss, 1);
      const float rstd = rsqrtf(ss * (1.0f / 64.0f) + EPS);
      const int kt = key >> 6, sub = (key >> 5) & 1, ql = key & 31;
#pragma unroll
      for (int i = 0; i < 4; ++i) { const int d0 = 32 * hf + 8 * i, sI = d0 >> 4, hh = (d0 >> 3) & 1; v4u w;
          w.x = pk2(kv[8 * i] * rstd * kg[d0], kv[8 * i + 1] * rstd * kg[d0 + 1]); w.y = pk2(kv[8 * i + 2] * rstd * kg[d0 + 2], kv[8 * i + 3] * rstd * kg[d0 + 3]);
          w.z = pk2(kv[8 * i + 4] * rstd * kg[d0 + 4], kv[8 * i + 5] * rstd * kg[d0 + 5]); w.w = pk2(kv[8 * i + 6] * rstd * kg[d0 + 6], kv[8 * i + 7] * rstd * kg[d0 + 7]);
          *(v4u*)(KF + ((((kt * 2 + sub) * 4 + sI) * 64 + ql + 32 * hh) * 8)) = w; } }
    { const int dv = F.tid & 63, grp = F.tid >> 6, kt = grp >> 1, sub = grp & 1, mt = dv >> 5, ql = dv & 31;
      const float* vp = MKV + (size_t)(b * 256 + 64 * kt + 32 * sub) * 512 + 256 + h * 64 + dv;
#pragma unroll
      for (int s2 = 0; s2 < 2; ++s2)
#pragma unroll
          for (int hh = 0; hh < 2; ++hh) { float v[8];
#pragma unroll
              for (int j = 0; j < 8; ++j) v[j] = vp[(size_t)(16 * s2 + 8 * (j >> 2) + 4 * hh + (j & 3)) * 512];
              v4u w; w.x = pk2(v[0], v[1]); w.y = pk2(v[2], v[3]); w.z = pk2(v[4], v[5]); w.w = pk2(v[6], v[7]);
              *(v4u*)(VF + (((((kt * 2 + mt) * 2 + sub) * 2 + s2) * 64 + ql + 32 * hh) * 8)) = w; } }
}

constexpr int MAP = 1032, MQP = 264;
__device__ __forceinline__ void mem_q_attn(Frame& F, const Args& A, int l, const XDeal xd, unsigned* cw, unsigned* cd) {
    LAS bf16* xa = (LAS bf16*)F.lds;
    LAS bf16* qt = (LAS bf16*)F.lds;
    const bf16* XB = (const bf16*)(F.ws + WS_XN); bf16* O2p = (bf16*)(F.ws + WS_O2);
    const bf16* WqT = (const bf16*)(F.ws + WS_WMQ) + (size_t)l * 256 * D;
    const float* qg = (const float*)A.in[31] + l * 64;
    const int lane = F.lane, w = F.wave, r = lane & 15, kq = lane >> 4, hh = lane >> 5, ql = lane & 31;
    for (int pp = xd.rank; pp < xd.U; pp += xd.nloc) { const int tile = 4 * xd.rt0 + pp;
        const size_t m0 = (size_t)tile * 64;
        __syncthreads();
        xd_wait(cw + (tile >> 2) * 64);
#pragma unroll
        for (int i = 0; i < 16; ++i) { const int p = F.tid + NTHR * i, row = p >> 7, c8 = (p & 127) * 8; *(LAS v4u*)(xa + row * MAP + c8) = *(const v4u*)(XB + (m0 + row) * D + c8); }
        __syncthreads();
        f32x4 acc[4][2];
#pragma unroll
        for (int tq = 0; tq < 4; ++tq) { acc[tq][0] = (f32x4){0.f, 0.f, 0.f, 0.f}; acc[tq][1] = acc[tq][0]; }
        {
            bf16x8 wa[2][8], wb[2][8];
#define MQ_LOADW(W, kb_) do { _Pragma("unroll") for (int nt_ = 0; nt_ < 2; ++nt_) _Pragma("unroll") for (int ks_ = 0; ks_ < 8; ++ks_) W[nt_][ks_] = *(const bf16x8*)(WqT + (size_t)(32 * w + 16 * nt_ + r) * D + ((kb_) * 8 + ks_) * 32 + kq * 8); } while (0)
#define MQ_MMA(W, kb_) do { _Pragma("unroll") for (int ks_ = 0; ks_ < 8; ++ks_) _Pragma("unroll") for (int tq_ = 0; tq_ < 4; ++tq_) { const bf16x8 af_ = *(const LAS bf16x8*)(xa + (16 * tq_ + r) * MAP + ((kb_) * 8 + ks_) * 32 + kq * 8); \
                acc[tq_][0] = __builtin_amdgcn_mfma_f32_16x16x32_bf16(W[0][ks_], af_, acc[tq_][0], 0, 0, 0); acc[tq_][1] = __builtin_amdgcn_mfma_f32_16x16x32_bf16(W[1][ks_], af_, acc[tq_][1], 0, 0, 0); } } while (0)
            MQ_LOADW(wa, 0); MQ_LOADW(wb, 1); MQ_MMA(wa, 0); MQ_LOADW(wa, 2); MQ_MMA(wb, 1); MQ_LOADW(wb, 3); MQ_MMA(wa, 2); MQ_MMA(wb, 3);
#undef MQ_LOADW
#undef MQ_MMA
        }
        __syncthreads();
#pragma unroll
        for (int tq = 0; tq < 4; ++tq)
#pragma unroll
            for (int nt = 0; nt < 2; ++nt) *(LAS v2u*)(qt + (16 * tq + r) * MQP + 32 * w + 16 * nt + 4 * kq) = pack4(acc[tq][nt]);
        __syncthreads();
        const int h = w >> 1, half = w & 1, bh = (int)(m0 >> 13) * 4 + h;
        const bf16* KF = (const bf16*)(F.ws + WS_MKF) + (size_t)bh * 16384; const bf16* VF = (const bf16*)(F.ws + WS_MVF) + (size_t)bh * 16384;
        bf16x8 qf[4];
        { float q[32]; float ss = 0.f;
#pragma unroll
          for (int s = 0; s < 4; ++s) { const v4u ww = *(const LAS v4u*)(qt + (32 * half + ql) * MQP + h * 64 + 16 * s + 8 * hh);
              q[8 * s] = bflo(ww.x); q[8 * s + 1] = bfhi(ww.x); q[8 * s + 2] = bflo(ww.y); q[8 * s + 3] = bfhi(ww.y); q[8 * s + 4] = bflo(ww.z); q[8 * s + 5] = bfhi(ww.z); q[8 * s + 6] = bflo(ww.w); q[8 * s + 7] = bfhi(ww.w); }
#pragma unroll
          for (int i = 0; i < 32; ++i) ss += q[i] * q[i];
          ss += shx(ss, 32);
          const float rstd = rsqrtf(ss * (1.0f / 64.0f) + EPS) * (0.125f * 1.4426950408889634f);
#pragma unroll
          for (int s = 0; s < 4; ++s) { const int d = 16 * s + 8 * hh; v4u pw;
              pw.x = pk2(q[8 * s] * rstd * qg[d], q[8 * s + 1] * rstd * qg[d + 1]); pw.y = pk2(q[8 * s + 2] * rstd * qg[d + 2], q[8 * s + 3] * rstd * qg[d + 3]);
              pw.z = pk2(q[8 * s + 4] * rstd * qg[d + 4], q[8 * s + 5] * rstd * qg[d + 5]); pw.w = pk2(q[8 * s + 6] * rstd * qg[d + 6], q[8 * s + 7] * rstd * qg[d + 7]);
              qf[s] = __builtin_bit_cast(bf16x8, pw); } }
        f32x16 o[2];
#pragma unroll
        for (int i = 0; i < 16; ++i) { o[0][i] = 0.f; o[1][i] = 0.f; }
        float lrun = 0.f;
#pragma unroll 1
        for (int kt = 0; kt < 4; ++kt) {
            bf16x8 kf[2][4], vf[2][2][2];
#pragma unroll
            for (int sub = 0; sub < 2; ++sub)
#pragma unroll
                for (int s = 0; s < 4; ++s) kf[sub][s] = *(const bf16x8*)(KF + ((((kt * 2 + sub) * 4 + s) * 64 + lane) * 8));
#pragma unroll
            for (int mt = 0; mt < 2; ++mt)
#pragma unroll
                for (int sub = 0; sub < 2; ++sub)
#pragma unroll
                    for (int s2 = 0; s2 < 2; ++s2) vf[mt][sub][s2] = *(const bf16x8*)(VF + (((((kt * 2 + mt) * 2 + sub) * 2 + s2) * 64 + lane) * 8));
            f32x16 st[2];
#pragma unroll
            for (int i = 0; i < 16; ++i) { st[0][i] = 0.f; st[1][i] = 0.f; }
#pragma unroll
            for (int s = 0; s < 4; ++s) { st[0] = __builtin_amdgcn_mfma_f32_32x32x16_bf16(kf[0][s], qf[s], st[0], 0, 0, 0); st[1] = __builtin_amdgcn_mfma_f32_32x32x16_bf16(kf[1][s], qf[s], st[1], 0, 0, 0); }
            float ps = 0.f;
#pragma unroll
            for (int sub = 0; sub < 2; ++sub)
#pragma unroll
                for (int i = 0; i < 16; ++i) { const float p = __builtin_amdgcn_exp2f(fminf(st[sub][i], 100.0f)); st[sub][i] = p; ps += p; }
            lrun += ps;
#pragma unroll
            for (int sub = 0; sub < 2; ++sub)
#pragma unroll
                for (int s2 = 0; s2 < 2; ++s2) { v4u pw; pw.x = pk2(st[sub][8 * s2], st[sub][8 * s2 + 1]); pw.y = pk2(st[sub][8 * s2 + 2], st[sub][8 * s2 + 3]); pw.z = pk2(st[sub][8 * s2 + 4], st[sub][8 * s2 + 5]); pw.w = pk2(st[sub][8 * s2 + 6], st[sub][8 * s2 + 7]);
                    const bf16x8 pf = __builtin_bit_cast(bf16x8, pw);
                    o[0] = __builtin_amdgcn_mfma_f32_32x32x16_bf16(vf[0][sub][s2], pf, o[0], 0, 0, 0); o[1] = __builtin_amdgcn_mfma_f32_32x32x16_bf16(vf[1][sub][s2], pf, o[1], 0, 0, 0); }
        }
        const float lt = lrun + shx(lrun, 32), il = 1.0f / lt;
        const size_t m = m0 + 32 * half + ql;
#pragma unroll
        for (int mt = 0; mt < 2; ++mt)
#pragma unroll
            for (int g = 0; g < 4; ++g) { v2u wv; wv.x = pk2(o[mt][4 * g] * il, o[mt][4 * g + 1] * il); wv.y = pk2(o[mt][4 * g + 2] * il, o[mt][4 * g + 3] * il);
                *(v2u*)(O2p + m * 256 + h * 64 + 32 * mt + 8 * g + 4 * hh) = wv; }
        xd_signal(cd + (tile >> 2) * 64);
    }
    __syncthreads();
}

constexpr int RWP = 1028, RLP = 40;
__device__ __forceinline__ void norm_router(Frame& F, const Args& A, int l, const XDeal xd, unsigned* cw) {
    const float* g = (const float*)A.in[33] + l * D; const bf16* wrf = (const bf16*)(F.ws + WS_WRT) + (size_t)l * 2 * 32 * RW_KS;
    const float* bg = (const float*)A.in[35] + l * 4; const float* be = (const float*)A.in[37] + l * 32;
    int* EID = (int*)(F.ws + WS_EID); float* GATE = (float*)(F.ws + WS_GATE); int* ROWTOK = (int*)(F.ws + WS_ROWTOK);
    GAS unsigned* cnt = F.ctl + CW_CNT + l * 32 * 64;
    LAS float* rs = (LAS float*)F.lds;
    LAS float* lg = rs + 64;
    const int n = F.lane & 15, kq = F.lane >> 4;
    bf16x8 wh[4][3], wo[4][3];
#pragma unroll
    for (int ks = 0; ks < 4; ++ks) { const bf16* p = wrf + (size_t)(4 * F.wave + ks) * RW_KS; const int o2 = 1024 + (kq * 4 + (n & 3)) * 8;
        wh[ks][0] = *(const bf16x8*)(p + F.lane * 8); wh[ks][1] = *(const bf16x8*)(p + 512 + F.lane * 8); wh[ks][2] = *(const bf16x8*)(p + o2);
        wo[ks][0] = *(const bf16x8*)(p + 32 * RW_KS + F.lane * 8); wo[ks][1] = *(const bf16x8*)(p + 32 * RW_KS + 512 + F.lane * 8); wo[ks][2] = *(const bf16x8*)(p + 32 * RW_KS + o2); }
    for (int pp = xd.rank; pp < xd.U; pp += xd.nloc) { const int rb = 4 * xd.rt0 + pp;
        const int m0 = rb * 64;
        __syncthreads();
        xd_wait(cw + (rb >> 2) * 64);
        {
            const int mw = m0 + 8 * F.wave; bf16* xnp = (bf16*)(F.ws + WS_XN);
#define NR_LOAD(R, m_) do { _Pragma("unroll") for (int j_ = 0; j_ < 4; ++j_) R[j_] = *(const f32x4*)((const float*)(F.out + (size_t)(m_) * D) + 4 * F.lane + 256 * j_); } while (0)
#define NR_DONE(R, m_, i_) do { float ss_ = 0.f; _Pragma("unroll") for (int j_ = 0; j_ < 4; ++j_) ss_ += (R[j_].x * R[j_].x + R[j_].y * R[j_].y) + (R[j_].z * R[j_].z + R[j_].w * R[j_].w); \
                const float rs_ = rsqrtf(wave_sum(ss_) * (1.0f / 1024.0f) + EPS); if (F.lane == 0) rs[8 * F.wave + (i_)] = rs_; \
                _Pragma("unroll") for (int j_ = 0; j_ < 4; ++j_) { const f32x4 h_ = R[j_] * rs_ * *(const f32x4*)(g + 4 * F.lane + 256 * j_); v2u o_; o_.x = pk2(h_.x, h_.y); o_.y = pk2(h_.z, h_.w); \
                    *(v2u*)(xnp + (size_t)(m_) * D + 4 * F.lane + 256 * j_) = o_; } } while (0)
            f32x4 RA[4], RB[4]; NR_LOAD(RA, mw); NR_LOAD(RB, mw + 1);
#pragma unroll
            for (int st = 0; st < 4; ++st) {
                NR_DONE(RA, mw + 2 * st, 2 * st); NR_DONE(RB, mw + 2 * st + 1, 2 * st + 1);
                const int trow = 8 * (n >> 1) + 2 * st + (n & 1);
                const float* xr = (const float*)(F.out + (size_t)(m0 + trow) * D) + 128 * F.wave + kq * 8;
                f32x4 xv[4][2];
#pragma unroll
                for (int ks = 0; ks < 4; ++ks) { xv[ks][0] = *(const f32x4*)(xr + ks * 32); xv[ks][1] = *(const f32x4*)(xr + ks * 32 + 4); }
                if (st < 3) { NR_LOAD(RA, mw + 2 * st + 2); NR_LOAD(RB, mw + 2 * st + 3); }
                f32x4 a0 = (f32x4){0.f, 0.f, 0.f, 0.f}, a1 = a0, a2 = a0;
#pragma unroll
                for (int ks = 0; ks < 4; ++ks) { v4u xh, xl; const f32x4 p = xv[ks][0], q = xv[ks][1];
                    xh.x = pk2(p.x, p.y); xh.y = pk2(p.z, p.w); xh.z = pk2(q.x, q.y); xh.w = pk2(q.z, q.w);
                    xl.x = pk2(p.x - bflo(xh.x), p.y - bfhi(xh.x)); xl.y = pk2(p.z - bflo(xh.y), p.w - bfhi(xh.y)); xl.z = pk2(q.x - bflo(xh.z), q.y - bfhi(xh.z)); xl.w = pk2(q.z - bflo(xh.w), q.w - bfhi(xh.w));
                    const bf16x8 bh = __builtin_bit_cast(bf16x8, xh), bl = __builtin_bit_cast(bf16x8, xl);
                    a0 = __builtin_amdgcn_mfma_f32_16x16x32_bf16(wh[ks][0], bh, a0, 0, 0, 0); a1 = __builtin_amdgcn_mfma_f32_16x16x32_bf16(wh[ks][1], bh, a1, 0, 0, 0); a2 = __builtin_amdgcn_mfma_f32_16x16x32_bf16(wh[ks][2], bh, a2, 0, 0, 0);
                    a0 = __builtin_amdgcn_mfma_f32_16x16x32_bf16(wo[ks][0], bh, a0, 0, 0, 0); a1 = __builtin_amdgcn_mfma_f32_16x16x32_bf16(wo[ks][1], bh, a1, 0, 0, 0); a2 = __builtin_amdgcn_mfma_f32_16x16x32_bf16(wo[ks][2], bh, a2, 0, 0, 0);
                    a0 = __builtin_amdgcn_mfma_f32_16x16x32_bf16(wh[ks][0], bl, a0, 0, 0, 0); a1 = __builtin_amdgcn_mfma_f32_16x16x32_bf16(wh[ks][1], bl, a1, 0, 0, 0); a2 = __builtin_amdgcn_mfma_f32_16x16x32_bf16(wh[ks][2], bl, a2, 0, 0, 0); }
                LAS float* lrow = lg + (F.wave * 64 + trow) * RLP + 4 * kq;
                *(LAS f32x4*)(lrow) = a0; *(LAS f32x4*)(lrow + 16) = a1; if (kq == 0) *(LAS f32x4*)(lrow + 32) = a2;
            }
#undef NR_LOAD
#undef NR_DONE
        }
        __syncthreads();
        if (F.tid < 64) { const int m = m0 + F.tid; const LAS float* lr = lg + F.tid * RLP; const float sc = rs[F.tid];
#define LSUM(j_) (((lr[(j_)] + lr[64 * RLP + (j_)]) + (lr[2 * 64 * RLP + (j_)] + lr[3 * 64 * RLP + (j_)])) + ((lr[4 * 64 * RLP + (j_)] + lr[5 * 64 * RLP + (j_)]) + (lr[6 * 64 * RLP + (j_)] + lr[7 * 64 * RLP + (j_)])))
            const float g0 = LSUM(0) * sc + bg[0], g1 = LSUM(1) * sc + bg[1], g2 = LSUM(2) * sc + bg[2], g3 = LSUM(3) * sc + bg[3];
            int gi = 0; float gm = g0; if (g1 > gm) { gm = g1; gi = 1; } if (g2 > gm) { gm = g2; gi = 2; } if (g3 > gm) { gm = g3; gi = 3; }
            const float gwt = 1.0f / (expf(g0 - gm) + expf(g1 - gm) + expf(g2 - gm) + expf(g3 - gm));
            float e[8];
#pragma unroll
            for (int i = 0; i < 8; ++i) e[i] = LSUM(4 + gi * 8 + i) * sc + be[gi * 8 + i];
#undef LSUM
            int i1 = 0; float m1 = e[0];
#pragma unroll
            for (int i = 1; i < 8; ++i) if (e[i] > m1) { m1 = e[i]; i1 = i; }
            int i2 = -1; float m2 = -3.0e38f;
#pragma unroll
            for (int i = 0; i < 8; ++i) if (i != i1 && e[i] > m2) { m2 = e[i]; i2 = i; }
            const float e2 = expf(m2 - m1), den = 1.0f / (1.0f + e2);
            const int ex0 = gi * 8 + i1, ex1 = gi * 8 + i2;
            EID[2 * m] = ex0; EID[2 * m + 1] = ex1; GATE[2 * m] = gwt * den; GATE[2 * m + 1] = gwt * e2 * den;
            __hip_atomic_fetch_add(cnt + ex0 * 64, 1u, __ATOMIC_RELAXED, __HIP_MEMORY_SCOPE_AGENT); __hip_atomic_fetch_add(cnt + ex1 * 64, 1u, __ATOMIC_RELAXED, __HIP_MEMORY_SCOPE_AGENT); }
        __syncthreads();
    }
}

__device__ __forceinline__ void moe_tables(Frame& F, int l) {
    LAS int* T = (LAS int*)(F.lds + TBL_OFF);
    __syncthreads();
    if (F.tid < 64) {
        GAS unsigned* cnt = F.ctl + CW_CNT + l * 32 * 64;
        const int lane = F.tid;
        const int cval = (lane < NEXP) ? (int)__hip_atomic_load(cnt + lane * 64, __ATOMIC_RELAXED, __HIP_MEMORY_SCOPE_AGENT) : 0;
        const int nt = (cval + 255) >> 8;
        int pre = 0;
        { int run = 0;
#pragma unroll 1
          for (int e = 0; e < NEXP; ++e) { run += __builtin_amdgcn_readlane(nt, e); if (lane == e) pre = run; }
          if (lane >= NEXP) pre = run; }
        const int rt0 = pre - nt;
        if (lane < NEXP) { T[lane] = rt0 * 256; for (int i = 0; i < nt; ++i) T[64 + rt0 + i] = lane; }
        if (lane == NEXP - 1) T[32] = pre;
    }
    __syncthreads();
}
__device__ __forceinline__ void moe_dispatch(Frame& F, int l, const XDeal xd) {
    moe_tables(F, l);
    const LAS int* T = (const LAS int*)(F.lds + TBL_OFF);
    const int* EID = (const int*)(F.ws + WS_EID); const float* GATE = (const float*)(F.ws + WS_GATE);
    int* ROWTOK = (int*)(F.ws + WS_ROWTOK); float* ROWGATE = (float*)(F.ws + WS_ROWGATE);
    GAS unsigned* cur = F.ctl + CW_CUR + l * 32 * 64;
    for (int pp = xd.rank; pp < xd.U; pp += xd.nloc) if (F.tid < 128) { const int a = (4 * xd.rt0 + pp) * 128 + F.tid;
        { const int e = EID[a]; const unsigned slot = __hip_atomic_fetch_add(cur + e * 64, 1u, __ATOMIC_RELAXED, __HIP_MEMORY_SCOPE_AGENT);
            const int row = T[e] + (int)slot; ROWTOK[row] = a; ROWGATE[row] = GATE[a]; } }
}

#ifndef MOE_ALIGN
#define MOE_ALIGN true
#endif
#ifndef MOE_SP2
#define MOE_SP2 true
#endif
constexpr int NPH = 14;
__global__ void __launch_bounds__(NTHR, 2) fwd_kernel(Args args) {
    extern __shared__ __attribute__((aligned(16))) unsigned char lds[];
    Frame F;
    F.lds = (LAS unsigned char*)lds; F.MISC = (volatile LAS unsigned*)(F.lds + MISC_OFF);
    F.tid = threadIdx.x; F.lane = F.tid & 63; F.wave = __builtin_amdgcn_readfirstlane(F.tid >> 6); F.bid = blockIdx.x; F.G = gridDim.x;
    F.ws = (GAS unsigned char*)args.ws; F.out = (GAS float*)args.out; F.ctl = (GAS unsigned*)(args.ws + WS_CTL);
    for (int u = F.tid; u < (LDS_BYTES - LDSCTL_OFF) / 4; u += NTHR) ((LAS unsigned*)(F.lds + LDSCTL_OFF))[u] = 0u;
    __syncthreads();
    const int lo = args.ph_lo, hi = args.ph_hi;
    const bool multi = (hi - lo) > 1;
    XcdBarrier bar; bar.bar = (unsigned*)(F.ctl + CW_BAR); bar.x = 0; bar.st = nullptr;
    if (multi) bar = xcd_barrier_post((unsigned*)(F.ctl + CW_BAR), F.MISC + 8);
#ifndef PHASE_MASK
#define PHASE_MASK 0xFFFFFFFFu
#endif
#define PH_ON(k) (((PHASE_MASK) >> (k)) & 1u)
#ifndef REP_MASK
#define REP_MASK 0u
#endif
#ifndef REP_N
#define REP_N 2
#endif
#define REPS(k) for (int rep_ = 0; rep_ < ((((REP_MASK) >> (k)) & 1u) ? REP_N : 1); ++rep_)
#define IN(k) (lo <= (k) && (k) < hi)
#define SEAM(k) do { if (IN(k) && IN((k) + 1)) xcd_barrier<false>(bar); } while (0)
#define SEAM_LIGHT(k) do { if (IN(k) && IN((k) + 1)) xcd_barrier<true>(bar); } while (0)
#define LAUNDER() do { asm volatile("" : "+s"(F.ws), "+s"(F.out), "+s"(F.ctl)); { int t_ = threadIdx.x; asm volatile("" : "+v"(t_)); F.tid = t_; } F.lane = F.tid & 63; F.wave = __builtin_amdgcn_readfirstlane(F.tid >> 6); } while (0)
    LAS unsigned char* ring = F.lds;
#define XN ((bf16*)(F.ws + WS_XN))
#define MIX ((bf16*)(F.ws + WS_MIX))
#define PROJ ((bf16*)(F.ws + WS_PROJ))
#define Q2 ((bf16*)(F.ws + WS_Q2))
#define O2 ((bf16*)(F.ws + WS_O2))
#define HS ((bf16*)(F.ws + WS_HS))
#define HH ((bf16*)(F.ws + WS_H))
#define YM ((bf16*)(F.ws + WS_YM))

    if (PH_ON(14) && IN(0)) REPS(14) { LAUNDER(); p0_prologue(F, args); }
    SEAM(0);
    for (int l = 0; l < DEPTH; ++l) {
        const int pb = 1 + l * NPH;
        if (PH_ON(0) && IN(pb + 0)) REPS(0) {
#define XD1_SETUP() LAUNDER(); const int nloc_ = __builtin_amdgcn_readfirstlane((int)F.MISC[8]), nx_ = __builtin_amdgcn_readfirstlane((int)F.MISC[9]), xi_ = __builtin_amdgcn_readfirstlane((int)F.MISC[10]), rank_ = __builtin_amdgcn_readfirstlane((int)F.MISC[11]); \
            const int rtA_ = (xi_ * 64) / nx_, rtB_ = ((xi_ + 1) * 64) / nx_; const XDeal xd{rtA_, 4 * (rtB_ - rtA_), rank_, nloc_}; unsigned* c1 = (unsigned*)(F.ctl + CW_XC + (8 + l) * 64 * 64); (void)xd; (void)c1
            { LAUNDER();
              if (l == 0) { pg8::Gemm g{(const bf16*)(F.ws + WS_MN), (const bf16*)(F.ws + WS_WMKV), 512, 512, D}; pg8::StaticOrder S; S.init(512, 512, F.G, F.bid);
                  pg8::EpiF32 E{(float*)(F.ws + WS_MKV), 512}; pg8::gemm_phase<pg8::EpiF32, pg8::StaticOrder, true, true>(ring, g, S, E); } }
            { XD1_SETUP();
              if (l > 0) { unsigned* c14p = (unsigned*)(F.ctl + CW_XC + (10 + l - 1) * 64 * 64);
                  for (int p = xd.rank; p < 11 * (rtB_ - rtA_); p += xd.nloc) xd_wait(c14p + (xd.rt0 + p / 11) * 64); }
              pg8::Gemm g{XN, (const bf16*)(F.ws + WS_WIN) + (size_t)l * NINP * D, M, NINP, D};
              pg8::XOrder S{xd.rt0, 11 * (rtB_ - rtA_), xd.rank, xd.nloc, c1, 11};
              pg8::EpiBf16<0> E{PROJ, NINP, nullptr, 0, 0, 1.f, (rtB_ < 64 && (rtB_ & 31) != 0) ? rtB_ - 1 : -1};
              pg8::gemm_phase<pg8::EpiBf16<0>, pg8::XOrder, true, true>(ring, g, S, E); S.flush(); }
            { XD1_SETUP(); if (l > 0) xd_wait_blocks((unsigned*)(F.ctl + CW_XC + 12 * 64 * 64 + (l - 1) * 64), (unsigned)F.G);
              rwkv_prep(F, args, l, xd, c1); }
            { XD1_SETUP(); mla_prep(F, args, l, xd); }
            { XD1_SETUP(); gmlp_stage(F, args, l, xd); }
#undef XD1_SETUP
        }
        SEAM(pb + 0);
        if (PH_ON(2) && IN(pb + 2)) REPS(2) { LAUNDER();
            { int* ROWTOK = (int*)(F.ws + WS_ROWTOK);
#pragma clang loop vectorize(disable) interleave(disable) unroll(disable)
              for (int i = F.bid * NTHR + F.tid; i < PROWS; i += F.G * NTHR) ROWTOK[i] = -1; }
            if (l == 0) memkv_arrange(F, args); LAUNDER(); rwkv_state_scan(F); attn_mfma(F); }
        SEAM(pb + 2);
        if (PH_ON(4) && IN(pb + 4)) REPS(4) {
#define XD_SETUP() LAUNDER(); const int nloc_ = __builtin_amdgcn_readfirstlane((int)F.MISC[8]), nx_ = __builtin_amdgcn_readfirstlane((int)F.MISC[9]), xi_ = __builtin_amdgcn_readfirstlane((int)F.MISC[10]), rank_ = __builtin_amdgcn_readfirstlane((int)F.MISC[11]); \
            const int rtA_ = (xi_ * 64) / nx_, rtB_ = ((xi_ + 1) * 64) / nx_; const XDeal xd{rtA_, 4 * (rtB_ - rtA_), rank_, nloc_}; \
            unsigned* c5 = (unsigned*)(F.ctl + CW_XC + (l * 3 + 0) * 64 * 64); unsigned* c7 = (unsigned*)(F.ctl + CW_XC + (l * 3 + 1) * 64 * 64); unsigned* c9 = (unsigned*)(F.ctl + CW_XC + (l * 3 + 2) * 64 * 64); unsigned* c4 = (unsigned*)(F.ctl + CW_XC + (6 + l) * 64 * 64); (void)c4; (void)c5; (void)c7; (void)c9
            { XD_SETUP(); attn_merge(F, xd); }
            { XD_SETUP(); rwkv_out(F, args, l, xd, c4); }
            { XD_SETUP(); for (int pp = xd.rank; pp < xd.U; pp += xd.nloc) xd_wait(c4 + (xd.rt0 + (pp >> 2)) * 64);
              pg8::Gemm g{MIX, (const bf16*)(F.ws + WS_WOUT) + (size_t)l * D * D, M, D, D}; pg8::XOrder S{xd.rt0, xd.U, xd.rank, xd.nloc, c5};
              pg8::EpiResXB E{l == 0 ? (const float*)args.in[0] : (const float*)F.out, (float*)F.out, XN, D};
              pg8::gemm_phase<pg8::EpiResXB, pg8::XOrder, true, true>(ring, g, S, E); S.flush(); }
            { XD_SETUP(); mem_q_attn(F, args, l, xd, c5, c7); }
            { XD_SETUP(); for (int pp = xd.rank; pp < xd.U; pp += xd.nloc) xd_wait(c7 + (xd.rt0 + (pp >> 2)) * 64);
              pg8::Gemm g{O2, (const bf16*)(F.ws + WS_WMO) + (size_t)l * D * 256, M, D, 256}; pg8::XOrder S{xd.rt0, xd.U, xd.rank, xd.nloc, c9};
              pg8::EpiResF32 E{(const float*)F.out, (float*)F.out, D};
              pg8::gemm_phase<pg8::EpiResF32, pg8::XOrder, true, true>(ring, g, S, E); S.flush(); }
            { XD_SETUP(); norm_router(F, args, l, xd, c9); }
#undef XD_SETUP
        }
        SEAM_LIGHT(pb + 4);
        if (PH_ON(10) && IN(pb + 10)) REPS(10) { LAUNDER();
            const int nloc_ = __builtin_amdgcn_readfirstlane((int)F.MISC[8]), nx_ = __builtin_amdgcn_readfirstlane((int)F.MISC[9]), xi_ = __builtin_amdgcn_readfirstlane((int)F.MISC[10]), rank_ = __builtin_amdgcn_readfirstlane((int)F.MISC[11]);
            const int rtA_ = (xi_ * 64) / nx_, rtB_ = ((xi_ + 1) * 64) / nx_; const XDeal xd{rtA_, 4 * (rtB_ - rtA_), rank_, nloc_};
            moe_dispatch(F, l, xd); }
        SEAM(pb + 10);
        if (PH_ON(11) && IN(pb + 11)) REPS(11) { LAUNDER(); moe_tables(F, l); const LAS int* T = (const LAS int*)(F.lds + TBL_OFF);
            const int nrt = __builtin_amdgcn_readfirstlane(T[32]);
            const int nloc = __builtin_amdgcn_readfirstlane((int)F.MISC[8]), nx = __builtin_amdgcn_readfirstlane((int)F.MISC[9]), xi = __builtin_amdgcn_readfirstlane((int)F.MISC[10]), rank = __builtin_amdgcn_readfirstlane((int)F.MISC[11]);
            const int rtA = (xi * nrt) / nx, rtB = ((xi + 1) * nrt) / nx;
            pg8::MoeOrderX S{rtA, 4 * (rtB - rtA), rank, nloc, 0, (const PG8_LAS int*)(T + 64), (unsigned*)(F.ctl + CW_MD + l * 160 * 64)};
            LAS unsigned* GT = (LAS unsigned*)(F.lds + GT_OFF);
            { const int* ROWTOK = (const int*)(F.ws + WS_ROWTOK);
#pragma unroll 1
              for (int ui = 0; ui < GT_UNITS; ++ui) { pg8::Unit u; if (!S.next(ui, u)) break;
                  if (F.tid < 256) { const int a = ROWTOK[u.pm * 256 + F.tid]; GT[ui * 256 + F.tid] = (unsigned)((a < 0 ? 0 : a) >> 1) * (unsigned)(D * 2); } }
              __syncthreads(); }
            { pg8::Gemm g{(const bf16*)(F.ws + WS_XN), (const bf16*)(F.ws + WS_W13) + (size_t)l * NEXP * 1024 * D, PROWS, 1024, D, (const PG8_LAS unsigned*)GT};
              pg8::EpiSwiGLU E{HH, 512};
              pg8::gemm_phase<pg8::EpiSwiGLU, pg8::MoeOrderX, MOE_ALIGN, MOE_SP2, true>(ring, g, S, E); }
            { pg8::MoeOrderX S2 = S; S2.mode = 1;
              pg8::Gemm g{HH, (const bf16*)(F.ws + WS_W2) + (size_t)l * NEXP * D * 512, PROWS, 1024, 512};
              pg8::EpiMoeOut E{YM, (const int*)(F.ws + WS_ROWTOK), (const float*)(F.ws + WS_ROWGATE)};
              pg8::gemm_phase<pg8::EpiMoeOut, pg8::MoeOrderX, MOE_ALIGN, MOE_SP2>(ring, g, S2, E); }
        }
        SEAM(pb + 11);
        if (PH_ON(13) && IN(pb + 13)) REPS(13) { LAUNDER();
            const int nloc_ = __builtin_amdgcn_readfirstlane((int)F.MISC[8]), nx_ = __builtin_amdgcn_readfirstlane((int)F.MISC[9]), xi_ = __builtin_amdgcn_readfirstlane((int)F.MISC[10]), rank_ = __builtin_amdgcn_readfirstlane((int)F.MISC[11]);
            const int rtA_ = (xi_ * 64) / nx_, rtB_ = ((xi_ + 1) * 64) / nx_; unsigned* c14 = (unsigned*)(F.ctl + CW_XC + (10 + l) * 64 * 64);
            const float* gnx = l + 1 < DEPTH ? (const float*)args.in[3] + (l + 1) * D : nullptr;
            struct Row { f32x4 x[4]; v2u a[4], b[4]; };
#define ROW_LOAD(R, m_) do { const float* xi_ = (const float*)(F.out + (size_t)(m_) * D); const bf16* y0_ = YM + (size_t)(2 * (m_)) * D; const bf16* y1_ = y0_ + D; _Pragma("unroll") for (int j_ = 0; j_ < 4; ++j_) { \
                R.x[j_] = *(const f32x4*)(xi_ + 4 * F.lane + 256 * j_); R.a[j_] = *(const v2u*)(y0_ + 4 * F.lane + 256 * j_); R.b[j_] = *(const v2u*)(y1_ + 4 * F.lane + 256 * j_); } } while (0)
#define ROW_DONE(R, m_) do { float ss_ = 0.f; f32x4 v_[4]; _Pragma("unroll") for (int j_ = 0; j_ < 4; ++j_) { f32x4 t_ = R.x[j_]; \
                t_.x += bflo(R.a[j_].x) + bflo(R.b[j_].x); t_.y += bfhi(R.a[j_].x) + bfhi(R.b[j_].x); t_.z += bflo(R.a[j_].y) + bflo(R.b[j_].y); t_.w += bfhi(R.a[j_].y) + bfhi(R.b[j_].y); \
                *(f32x4*)((float*)(F.out + (size_t)(m_) * D) + 4 * F.lane + 256 * j_) = t_; v_[j_] = t_; ss_ += (t_.x * t_.x + t_.y * t_.y) + (t_.z * t_.z + t_.w * t_.w); } \
                if (gnx) { const float rs_ = rsqrtf(wave_sum(ss_) * (1.0f / 1024.0f) + EPS); _Pragma("unroll") for (int j_ = 0; j_ < 4; ++j_) { const f32x4 h_ = v_[j_] * rs_ * *(const f32x4*)(gnx + 4 * F.lane + 256 * j_); \
                    v2u o_; o_.x = pk2(h_.x, h_.y); o_.y = pk2(h_.z, h_.w); *(v2u*)(XN + (size_t)(m_) * D + 4 * F.lane + 256 * j_) = o_; } } } while (0)
#pragma unroll 1
            for (int pp = rank_; pp < 4 * (rtB_ - rtA_); pp += nloc_) { const int tile = 4 * rtA_ + pp, mw = tile * 64 + 8 * F.wave;
                Row RA, RB; ROW_LOAD(RA, mw);
#pragma unroll
                for (int i = 0; i < 8; i += 2) { ROW_LOAD(RB, mw + i + 1); ROW_DONE(RA, mw + i); if (i + 2 < 8) ROW_LOAD(RA, mw + i + 2); ROW_DONE(RB, mw + i + 1); }
                if (gnx) xd_signal(c14 + (tile >> 2) * 64); }
            if (gnx) { __syncthreads(); xd_block_done((unsigned*)(F.ctl + CW_XC + 12 * 64 * 64 + l * 64)); }
#undef ROW_LOAD
#undef ROW_DONE
        }
    }
#undef IN
#undef SEAM
#undef XN
#undef MIX
#undef PROJ
#undef Q2
#undef O2
#undef HS
#undef HH
#undef YM
}

#ifndef N_LAUNCH_MODE
#define N_LAUNCH_MODE 1
#endif
extern "C" void kernel_launch(void* const* d_in, const int* in_sizes, int n_in, void* d_out, int out_size, void* d_ws, size_t ws_size, hipStream_t stream) {
    static int grid = 0;
    if (grid == 0) {
        if (n_in != 41 || in_sizes[0] != M * D || out_size != M * D || ws_size < (size_t)512 * MiB) { fprintf(stderr, "kernel_launch: unexpected shapes (n_in %d, ws %zu)\n", n_in, ws_size); grid = -1; return; }
        int dev = 0, cus = 0;
        if (hipGetDevice(&dev) != hipSuccess || hipDeviceGetAttribute(&cus, hipDeviceAttributeMultiprocessorCount, dev) != hipSuccess) { grid = -1; return; }
        if (hipFuncSetAttribute((const void*)fwd_kernel, hipFuncAttributeMaxDynamicSharedMemorySize, LDS_BYTES) != hipSuccess) { grid = -1; return; }
        int per_cu = 0;
        if (hipOccupancyMaxActiveBlocksPerMultiprocessor(&per_cu, (const void*)fwd_kernel, NTHR, LDS_BYTES) != hipSuccess || per_cu < 1) { fprintf(stderr, "kernel_launch: occupancy query says %d\n", per_cu); }
        (void)hipGetLastError();
        grid = cus;
    }
    if (grid < 0) return;
    (void)hipMemsetAsync((char*)d_ws + WS_CTL, 0, CTL_ZERO_BYTES, stream);
    Args a{};
    for (int i = 0; i < 41; ++i) a.in[i] = d_in[i];
    a.out = (float*)d_out; a.ws = (unsigned char*)d_ws;
    const int nph = 1 + DEPTH * NPH;
    if (N_LAUNCH_MODE == 1) { a.ph_lo = 0; a.ph_hi = nph; hipLaunchKernelGGL(fwd_kernel, dim3(grid), dim3(NTHR), LDS_BYTES, stream, a); }
    else for (int p = 0; p < nph; ++p) { a.ph_lo = p; a.ph_hi = p + 1; hipLaunchKernelGGL(fwd_kernel, dim3(grid), dim3(NTHR), LDS_BYTES, stream, a); }
}
```

```cpp
#include <hip/hip_runtime.h>
#include <cstdio>
#include <cstdint>
namespace pg8 {
#define PG8_LAS __attribute__((address_space(3)))
typedef unsigned short bf16_t;
typedef short bf16x8 __attribute__((ext_vector_type(8)));
typedef float f32x4 __attribute__((ext_vector_type(4)));
typedef unsigned u32x4 __attribute__((ext_vector_type(4)));
constexpr int BM = 256, BK = 64, HALF = 128, HTB = HALF * BK * 2  , STAGE_BYTES = 8 * HTB, NXCD = 8, WGM = 8;

__host__ __device__ __forceinline__ int lds_byte(int r, int c) { const int st = (r >> 4) * 2 + (c >> 5), rr = r & 15, cc = c & 31, ob = rr * 64 + cc * 2; return st * 1024 + (ob ^ (((ob >> 9) & 1) << 5)); }
__host__ __device__ __forceinline__ void stage_rc(int b, int& R, int& C) { const int st = b / 1024, sb = b % 1024, swz = sb ^ (((sb >> 9) & 1) << 5); R = (st >> 1) * 16 + swz / 64; C = (st & 1) * 32 + (swz % 64) / 2; }
__host__ __device__ __forceinline__ int perm32(int rho) { const int n = rho >> 4, i = rho & 15; return 8 * (i >> 2) + 4 * n + (i & 3); }

struct Unit { int pm, pn; };
struct Gemm { const bf16_t* A; const bf16_t* Bt; int M, N, K; const PG8_LAS unsigned* gt = nullptr; };

struct StaticOrder {
    int nM, nN, nwg, G, c;
    __host__ __device__ void init(int M, int N, int G_, int c_) { nM = M / BM; nN = N / BM; nwg = nM * nN; G = G_; c = c_; }
    __host__ __device__ bool next(int i, Unit& u) const {
        const long L = (long)i * G + c; if (L >= nwg) return false;
        int wgid = (int)L; { const int q = nwg / NXCD, r = nwg % NXCD, xcd = wgid % NXCD, off = wgid / NXCD; wgid = (xcd < r ? xcd * (q + 1) : r * (q + 1) + (xcd - r) * q) + off; }
        const int nig = WGM * nN, gid = wgid / nig, fm = gid * WGM, gsz = (nM - fm) < WGM ? (nM - fm) : WGM;
        u.pm = fm + ((wgid % nig) % gsz); u.pn = (wgid % nig) / gsz; return true;
    }
    __device__ __forceinline__ void a_ready(const Unit&) const {}
    __device__ __forceinline__ void done(const Unit&) const {}
};

__device__ __forceinline__ unsigned cvt_pk_bf16(float lo, float hi) { unsigned r; asm volatile("v_cvt_pk_bf16_f32 %0, %1, %2" : "=v"(r) : "v"(lo), "v"(hi)); return r; }
typedef float f32x2 __attribute__((ext_vector_type(2)));
__device__ __forceinline__ f32x2 gelu_pk(f32x2 v) {
    const f32x2 av = __builtin_elementwise_abs(v), d = av * 0.2316418882f + 1.0f;
    f32x2 t; t.x = __builtin_amdgcn_rcpf(d.x); t.y = __builtin_amdgcn_rcpf(d.y);
    f32x2 q = t * 0.5307027145f + (-0.7265760135f); q = q * t + 0.7107068705f; q = q * t + (-0.142248368f); q = q * t + 0.127414796f; q = q * t;
    const f32x2 s = (v * v) * (-0.72134752044f);
    f32x2 e; e.x = __builtin_amdgcn_exp2f(s.x); e.y = __builtin_amdgcn_exp2f(s.y);
    const f32x2 m = v * (q * e), r = v - m;
    f32x2 o; o.x = v.x < 0.f ? m.x : r.x; o.y = v.y < 0.f ? m.y : r.y; return o;
}

template <int ACT  > struct EpiBf16 {
    static constexpr bool PERM = true, AFTER_DRAIN = false; static_assert(ACT == 0 || ACT == 1, "EpiBf16: ACT is 0 (none) or 1 (gelu_pk)");
    bf16_t* O; int ldc; const float* bias; int split_cols; size_t split_stride; float scale0;
    int coh_tile = -1;
    __device__ __forceinline__ void operator()(const f32x4 (&acc)[2][2][4][2], const Unit& u, int wr, int wc, int fr, int fq) const {
        const int row0 = u.pm * BM + wr * 64 + fr; int colt = u.pn * BM; bf16_t* base = O;
        float sc = 1.f; if (split_cols) { const int t = colt / split_cols; base += (size_t)t * split_stride; colt -= t * split_cols; if (t == 0) sc = scale0; }
        const int col0 = colt + wc * 32 + 8 * fq, bcol0 = u.pn * BM + wc * 32 + 8 * fq;
        f32x4 bv[2][2];
#pragma unroll
        for (int bj = 0; bj < 2; ++bj)
#pragma unroll
            for (int n = 0; n < 2; ++n) bv[bj][n] = bias ? *(const f32x4*)(bias + bcol0 + bj * HALF + 4 * n) : (f32x4){0.f, 0.f, 0.f, 0.f};
#pragma unroll
        for (int ai = 0; ai < 2; ++ai)
#pragma unroll
            for (int m = 0; m < 4; ++m) { bf16_t* rowp = base + (size_t)(row0 + ai * HALF + m * 16) * ldc + col0;
#pragma unroll
                for (int bj = 0; bj < 2; ++bj) { f32x4 v0 = acc[ai][bj][m][0] + bv[bj][0], v1 = acc[ai][bj][m][1] + bv[bj][1];
                    if (ACT == 1) { f32x2 a = gelu_pk((f32x2){v0[0], v0[1]}), b = gelu_pk((f32x2){v0[2], v0[3]}), c = gelu_pk((f32x2){v1[0], v1[1]}), d = gelu_pk((f32x2){v1[2], v1[3]});
                        v0 = (f32x4){a.x, a.y, b.x, b.y}; v1 = (f32x4){c.x, c.y, d.x, d.y}; }
                    v0 = v0 * sc; v1 = v1 * sc; u32x4 w; w.x = cvt_pk_bf16(v0[0], v0[1]); w.y = cvt_pk_bf16(v0[2], v0[3]); w.z = cvt_pk_bf16(v1[0], v1[1]); w.w = cvt_pk_bf16(v1[2], v1[3]);
                    if (u.pm == coh_tile) { unsigned long long* q_ = (unsigned long long*)(rowp + bj * HALF);
                        __hip_atomic_store(q_, (unsigned long long)w.x | ((unsigned long long)w.y << 32), __ATOMIC_RELAXED, __HIP_MEMORY_SCOPE_AGENT);
                        __hip_atomic_store(q_ + 1, (unsigned long long)w.z | ((unsigned long long)w.w << 32), __ATOMIC_RELAXED, __HIP_MEMORY_SCOPE_AGENT); }
                    else *(u32x4*)(rowp + bj * HALF) = w; } }
    }
};

struct EpiF32 {
    static constexpr bool PERM = false, AFTER_DRAIN = false;
    float* C; int ldc;
    __device__ __forceinline__ void operator()(const f32x4 (&acc)[2][2][4][2], const Unit& u, int wr, int wc, int fr, int fq) const {
        const int row0 = u.pm * BM + wr * 64 + fr, col0 = u.pn * BM + wc * 32 + 4 * fq;
#pragma unroll
        for (int ai = 0; ai < 2; ++ai)
#pragma unroll
            for (int m = 0; m < 4; ++m) { float* rowp = C + (size_t)(row0 + ai * HALF + m * 16) * ldc + col0;
#pragma unroll
                for (int bj = 0; bj < 2; ++bj)
#pragma unroll
                    for (int n = 0; n < 2; ++n) *(f32x4*)(rowp + bj * HALF + n * 16) = acc[ai][bj][m][n]; }
    }
};
struct EpiResF32 {
    static constexpr bool PERM = false, AFTER_DRAIN = false;
    const float* base; float* out; int ldc;
    __device__ __forceinline__ void operator()(const f32x4 (&acc)[2][2][4][2], const Unit& u, int wr, int wc, int fr, int fq) const {
        const int row0 = u.pm * BM + wr * 64 + fr, col0 = u.pn * BM + wc * 32 + 4 * fq;
#pragma unroll
        for (int ai = 0; ai < 2; ++ai)
#pragma unroll
            for (int m = 0; m < 4; ++m) { const size_t ro = (size_t)(row0 + ai * HALF + m * 16) * ldc + col0;
#pragma unroll
                for (int bj = 0; bj < 2; ++bj)
#pragma unroll
                    for (int n = 0; n < 2; ++n) { const f32x4 b = *(const f32x4*)(base + ro + bj * HALF + n * 16); *(f32x4*)(out + ro + bj * HALF + n * 16) = acc[ai][bj][m][n] + b; } }
    }
};
struct EpiResXB {
    static constexpr bool PERM = false, AFTER_DRAIN = false;
    const float* base; float* out; bf16_t* xb; int ldc;
    __device__ __forceinline__ void operator()(const f32x4 (&acc)[2][2][4][2], const Unit& u, int wr, int wc, int fr, int fq) const {
        const int row0 = u.pm * BM + wr * 64 + fr, col0 = u.pn * BM + wc * 32 + 4 * fq;
#pragma unroll
        for (int ai = 0; ai < 2; ++ai)
#pragma unroll
            for (int m = 0; m < 4; ++m) { const size_t ro = (size_t)(row0 + ai * HALF + m * 16) * ldc + col0;
#pragma unroll
                for (int bj = 0; bj < 2; ++bj)
#pragma unroll
                    for (int n = 0; n < 2; ++n) { const f32x4 v = acc[ai][bj][m][n] + *(const f32x4*)(base + ro + bj * HALF + n * 16); *(f32x4*)(out + ro + bj * HALF + n * 16) = v;
                        const unsigned long long w_ = (unsigned long long)cvt_pk_bf16(v[0], v[1]) | ((unsigned long long)cvt_pk_bf16(v[2], v[3]) << 32); *(unsigned long long*)(xb + ro + bj * HALF + n * 16) = w_; } }
    }
};
struct EpiBf16Rs {
    static constexpr bool PERM = true, AFTER_DRAIN = false;
    bf16_t* O; int ldc; const float* rss;
    __device__ __forceinline__ void operator()(const f32x4 (&acc)[2][2][4][2], const Unit& u, int wr, int wc, int fr, int fq) const {
        const int row0 = u.pm * BM + wr * 64 + fr, col0 = u.pn * BM + wc * 32 + 8 * fq;
#pragma unroll
        for (int ai = 0; ai < 2; ++ai)
#pragma unroll
            for (int m = 0; m < 4; ++m) { const int row = row0 + ai * HALF + m * 16; bf16_t* rowp = O + (size_t)row * ldc + col0;
                const float rs = rsqrtf(rss[row] * (1.0f / 1024.0f) + 1e-6f);
#pragma unroll
                for (int bj = 0; bj < 2; ++bj) { const f32x4 v0 = acc[ai][bj][m][0] * rs, v1 = acc[ai][bj][m][1] * rs;
                    u32x4 w; w.x = cvt_pk_bf16(v0[0], v0[1]); w.y = cvt_pk_bf16(v0[2], v0[3]); w.z = cvt_pk_bf16(v1[0], v1[1]); w.w = cvt_pk_bf16(v1[2], v1[3]);
                    *(u32x4*)(rowp + bj * HALF) = w; } }
    }
};
struct EpiSwiGLU {
    static constexpr bool PERM = true, AFTER_DRAIN = false;
    bf16_t* H; int ldh;
    __device__ __forceinline__ void operator()(const f32x4 (&acc)[2][2][4][2], const Unit& u, int wr, int wc, int fr, int fq) const {
        const int row0 = u.pm * BM + wr * 64 + fr, col0 = (u.pn & 3) * HALF + wc * 32 + 8 * fq;
#pragma unroll
        for (int ai = 0; ai < 2; ++ai)
#pragma unroll
            for (int m = 0; m < 4; ++m) { bf16_t* rowp = H + (size_t)(row0 + ai * HALF + m * 16) * ldh + col0;
                float o[8];
#pragma unroll
                for (int n = 0; n < 2; ++n)
#pragma unroll
                    for (int j = 0; j < 4; ++j) { const float a = acc[ai][0][m][n][j], b = acc[ai][1][m][n][j]; o[n * 4 + j] = a / (1.0f + __expf(-a)) * b; }
                u32x4 w; w.x = cvt_pk_bf16(o[0], o[1]); w.y = cvt_pk_bf16(o[2], o[3]); w.z = cvt_pk_bf16(o[4], o[5]); w.w = cvt_pk_bf16(o[6], o[7]);
                *(u32x4*)rowp = w; }
    }
};
struct EpiMoeOut {
    static constexpr bool PERM = true, AFTER_DRAIN = false;
    bf16_t* Y; const int* list; const float* listg; const PG8_LAS int* T;
    __device__ __forceinline__ void operator()(const f32x4 (&acc)[2][2][4][2], const Unit& u, int wr, int wc, int fr, int fq) const {
        const int e = u.pn >> 2, n_e = T[256 + e], loc0 = u.pm * BM - T[e] + wr * 64 + fr, col0 = (u.pn & 3) * BM + wc * 32 + 8 * fq;
#pragma unroll
        for (int ai = 0; ai < 2; ++ai)
#pragma unroll
            for (int m = 0; m < 4; ++m) { const int loc = loc0 + ai * HALF + m * 16;
                if (loc < n_e) { const int a = list[(e << 14) + loc]; const float gt = listg[(e << 14) + loc]; bf16_t* rowp = Y + (size_t)a * 1024 + col0;
#pragma unroll
                    for (int bj = 0; bj < 2; ++bj) { const f32x4 v0 = acc[ai][bj][m][0] * gt, v1 = acc[ai][bj][m][1] * gt;
                        u32x4 w; w.x = cvt_pk_bf16(v0[0], v0[1]); w.y = cvt_pk_bf16(v0[2], v0[3]); w.z = cvt_pk_bf16(v1[0], v1[1]); w.w = cvt_pk_bf16(v1[2], v1[3]);
                        *(u32x4*)(rowp + bj * HALF) = w; } } }
    }
};
struct MoeOrder {
    int total, G, c; const PG8_LAS int* tbl;
    __device__ __forceinline__ bool next(int i, Unit& u) const {
        int L;
        if ((G & 7) == 0) { const int per = (total + 7) >> 3, x = c & 7, j = c >> 3, pos = i * (G >> 3) + j; if (pos >= per) return false; L = x * per + pos; if (L >= total) return false; }
        else { L = i * G + c; if (L >= total) return false; }
        const int rt = L >> 2, ct = L & 3;
        const int e = __builtin_amdgcn_readfirstlane(tbl[rt]);
        u.pm = rt; u.pn = e * 4 + ct; return true;
    }
    __device__ __forceinline__ void a_ready(const Unit&) const {}
    __device__ __forceinline__ void done(const Unit&) const {}
};

struct MoeOrderX {
    int rt0, U, rank, nloc, mode; const PG8_LAS int* tbl; unsigned* cnt;
    __device__ __forceinline__ bool next(int i, Unit& u) const {
        int p;
        const int r = U % nloc, L = nloc - r;
        if (mode == 0 || r == 0) p = i * nloc + rank;
        else if (rank >= r) p = (i < 2) ? i * L + (rank - r) : 2 * L + (i - 2) * nloc + (rank - r);
        else p = 2 * L + i * nloc + (L + rank);
        if (p >= U) return false;
        const int rt = rt0 + (p >> 2);
        const int e = __builtin_amdgcn_readfirstlane(tbl[rt]);
        u.pm = rt; u.pn = e * 4 + (p & 3); return true;
    }
    __device__ __forceinline__ void a_ready(const Unit& u) const {
        if (mode == 1) { unsigned* c = cnt + u.pm * 64; unsigned sp = 0u;
            while (__hip_atomic_load(c, __ATOMIC_RELAXED, __HIP_MEMORY_SCOPE_AGENT) < 32u) { __builtin_amdgcn_s_sleep(2); if (++sp > (1u << 22)) break; }
            asm volatile("" ::: "memory"); }
    }
    __device__ __forceinline__ void done(const Unit& u) const {
        if (mode == 0) { asm volatile("s_waitcnt vmcnt(0)" ::: "memory");
            if ((threadIdx.x & 63) == 0) __hip_atomic_fetch_add(cnt + u.pm * 64, 1u, __ATOMIC_RELAXED, __HIP_MEMORY_SCOPE_AGENT); }
    }
};

struct XOrder {
    int rt0, U, rank, nloc; unsigned* done_cnt; int ncol = 4;
    mutable int pend = -1;
    __device__ __forceinline__ bool next(int i, Unit& u) const { const int p = i * nloc + rank; if (p >= U) return false; const int q = p / ncol; u.pm = rt0 + q; u.pn = p - q * ncol; return true; }
    __device__ __forceinline__ void a_ready(const Unit&) const {}
    __device__ __forceinline__ void signal(int rt) const {
        if ((threadIdx.x & 63) == 0) __hip_atomic_fetch_add(done_cnt + rt * 64, 1u, __ATOMIC_RELAXED, __HIP_MEMORY_SCOPE_AGENT);
    }
    __device__ __forceinline__ void done(const Unit& u) const { if (pend >= 0) signal(pend); pend = u.pm; }
    __device__ __forceinline__ void flush() const { asm volatile("s_waitcnt vmcnt(0)" ::: "memory"); if (pend >= 0) signal(pend); pend = -1; }
};

template <class Epi, class Sched, bool ALIGN_EPI = false, bool SP2 = false, bool GATHER = false>
__device__ __forceinline__ void gemm_phase(PG8_LAS unsigned char* lds, const Gemm g, const Sched& S, const Epi& E) {
    int tid_ = threadIdx.x; asm volatile("" : "+v"(tid_));
    const int tid = tid_, wid = __builtin_amdgcn_readfirstlane(tid >> 6), lane = tid & 63, wr = wid >> 2, wc = wid & 3, fr = lane & 15, fq = lane >> 4;
    const int K = g.K, nt = K / BK;
    unsigned voffA[2], voffB[2];
#pragma unroll
    for (int i = 0; i < 2; ++i) { int R, C; stage_rc(tid * 16 + i * 8192, R, C); const int Rb = Epi::PERM ? ((R & ~31) + perm32(R & 31)) : R;
        voffA[i] = (unsigned)(R * K + C) * 2u; voffB[i] = (unsigned)(Rb * K + C) * 2u; }
    const size_t kstep = (size_t)(BK * 2);
    const size_t hstep = (size_t)HALF * K * 2;
    const size_t tstep = 2 * hstep;
    const unsigned ldsw = (unsigned)wid * 1024u;
    const int aoff = lds_byte(wr * 64 + fr, fq * 8), boff = lds_byte(wc * 32 + fr, fq * 8);
#define PG8_SA(b, h) (((b) * 2 + (h)) * HTB)
#define PG8_SB(b, h) ((4 + (b) * 2 + (h)) * HTB)
#define PG8_STAGE(bufoff, gbase, voff) do { _Pragma("unroll") for (int _i = 0; _i < 2; ++_i) \
        __builtin_amdgcn_global_load_lds((const unsigned*)((const char*)(gbase) + (voff)[_i]), (PG8_LAS unsigned*)(lds + (bufoff) + ldsw + _i * 8192), 16, 0, 0); } while (0)
#define PG8_LDA(dst, b, h) do { _Pragma("unroll") for (int m = 0; m < 4; ++m) _Pragma("unroll") for (int k = 0; k < 2; ++k) dst[m][k] = *(const PG8_LAS bf16x8*)(lds + PG8_SA(b, h) + aoff + m * 2048 + k * 1024); } while (0)
#define PG8_LDB(dst, b, h) do { _Pragma("unroll") for (int n = 0; n < 2; ++n) _Pragma("unroll") for (int k = 0; k < 2; ++k) dst[n][k] = *(const PG8_LAS bf16x8*)(lds + PG8_SB(b, h) + boff + n * 2048 + k * 1024); } while (0)
#define PG8_MMA(ai, bj, At, Bt) do { __builtin_amdgcn_s_setprio(1); _Pragma("unroll") for (int m = 0; m < 4; ++m) _Pragma("unroll") for (int n = 0; n < 2; ++n) _Pragma("unroll") for (int k = 0; k < 2; ++k) \
        acc[ai][bj][m][n] = __builtin_amdgcn_mfma_f32_16x16x32_bf16(Bt[n][k], At[m][k], acc[ai][bj][m][n], 0, 0, 0); __builtin_amdgcn_s_setprio(0); } while (0)
#define PG8_WAIT_V(n) asm volatile("s_waitcnt vmcnt(" #n ")" ::: "memory")
#define PG8_WAIT_L(n) asm volatile("s_waitcnt lgkmcnt(" #n ")" ::: "memory")
#define PG8_BAR __builtin_amdgcn_s_barrier()
#define PG8_SCHED __builtin_amdgcn_sched_barrier(0)
    static_assert(!GATHER || SP2, "GATHER is written for the SP2 loop");
    unsigned vG[2][2] = {{0u, 0u}, {0u, 0u}};
#define PG8_LOADG(u_) do { int t3_ = threadIdx.x; asm volatile("" : "+v"(t3_)); _Pragma("unroll") for (int i_ = 0; i_ < 2; ++i_) { int R_, C_; stage_rc(t3_ * 16 + i_ * 8192, R_, C_); \
        _Pragma("unroll") for (int h_ = 0; h_ < 2; ++h_) vG[h_][i_] = g.gt[(u_) * 256 + h_ * HALF + R_] + (unsigned)C_ * 2u; } } while (0)
#define PG8_STAGEA(bufoff, base, h) do { if constexpr (GATHER) PG8_STAGE(bufoff, base, vG[h]); else PG8_STAGE(bufoff, (base) + ((h) ? hstep : (size_t)0), voffA); } while (0)
    Unit cur, nxt; int ui = 0;
    if (!S.next(0, cur)) return;
    if constexpr (GATHER) PG8_LOADG(0);
    f32x4 acc[2][2][4][2];
#pragma unroll
    for (int a = 0; a < 2; ++a)
#pragma unroll
        for (int b = 0; b < 2; ++b)
#pragma unroll
            for (int m = 0; m < 4; ++m)
#pragma unroll
                for (int n = 0; n < 2; ++n) acc[a][b][m][n] = (f32x4){0.f, 0.f, 0.f, 0.f};
    bf16x8 At[4][2], B0[2][2], B1[2][2];
    const char* cA = (const char*)g.A + (GATHER ? (size_t)0 : (size_t)cur.pm * tstep); const char* cB = (const char*)g.Bt + (size_t)cur.pn * tstep;
    S.a_ready(cur);
    if constexpr (SP2) {
        PG8_STAGE(PG8_SB(0, 0), cB, voffB); PG8_STAGE(PG8_SB(0, 1), cB + hstep, voffB); PG8_STAGEA(PG8_SA(0, 0), cA, 0); PG8_STAGEA(PG8_SA(0, 1), cA, 1);
        if (wr == 1) PG8_BAR;
        PG8_WAIT_V(2); PG8_BAR;
        PG8_STAGE(PG8_SB(1, 0), cB + kstep, voffB); PG8_STAGEA(PG8_SA(1, 0), cA + kstep, 0); PG8_STAGE(PG8_SB(1, 1), cB + hstep + kstep, voffB);
        PG8_WAIT_V(6); PG8_BAR;
    } else {
        PG8_STAGE(PG8_SB(0, 0), cB, voffB); PG8_STAGE(PG8_SA(0, 0), cA, voffA); PG8_STAGE(PG8_SB(0, 1), cB + hstep, voffB); PG8_STAGE(PG8_SA(0, 1), cA + hstep, voffA);
        if (wr == 1) PG8_BAR;
        PG8_WAIT_V(4); PG8_BAR;
        PG8_STAGE(PG8_SB(1, 0), cB + kstep, voffB); PG8_STAGE(PG8_SA(1, 0), cA + kstep, voffA); PG8_STAGE(PG8_SB(1, 1), cB + hstep + kstep, voffB);
        PG8_WAIT_V(6); PG8_BAR;
    }
    for (;;) {
        const bool has_next = S.next(ui + 1, nxt);
        const char* nA = (has_next && !GATHER) ? (const char*)g.A + (size_t)nxt.pm * tstep : cA; const char* nB = has_next ? (const char*)g.Bt + (size_t)nxt.pn * tstep : cB;
        for (int t = 0; t < nt; t += 2) {
            const bool last = (t == nt - 2);
            const char* a1 = cA + (size_t)(t + 1) * kstep;
            const char* a2 = last ? nA : cA + (size_t)(t + 2) * kstep; const char* b2 = last ? nB : cB + (size_t)(t + 2) * kstep;
            const char* a3 = a2 + kstep; const char* b3 = b2 + kstep;
            if (last && has_next) S.a_ready(nxt);
            if constexpr (SP2) {
            PG8_LDB(B0, 0, 0); PG8_LDB(B1, 0, 1); PG8_SCHED; PG8_LDA(At, 0, 0); PG8_STAGEA(PG8_SA(1, 1), a1, 1);
            if constexpr (GATHER) { if (last && has_next) PG8_LOADG(ui + 1); }
            PG8_WAIT_V(8); PG8_WAIT_L(0); PG8_BAR; PG8_MMA(0, 0, At, B0); PG8_MMA(0, 1, At, B1); PG8_BAR; PG8_SCHED;
            PG8_LDA(At, 0, 1); PG8_STAGE(PG8_SB(0, 0), b2, voffB); PG8_STAGE(PG8_SB(0, 1), b2 + hstep, voffB); PG8_STAGEA(PG8_SA(0, 0), a2, 0);
            PG8_WAIT_V(8); PG8_WAIT_L(0); PG8_BAR; PG8_MMA(1, 0, At, B0); PG8_MMA(1, 1, At, B1); PG8_BAR; PG8_SCHED;
            PG8_LDB(B0, 1, 0); PG8_LDB(B1, 1, 1); PG8_SCHED; PG8_LDA(At, 1, 0); PG8_STAGEA(PG8_SA(0, 1), a2, 1);
            PG8_WAIT_V(8); PG8_WAIT_L(0); PG8_BAR; PG8_MMA(0, 0, At, B0); PG8_MMA(0, 1, At, B1); PG8_BAR; PG8_SCHED;
            PG8_LDA(At, 1, 1); PG8_STAGE(PG8_SB(1, 0), b3, voffB); PG8_STAGE(PG8_SB(1, 1), b3 + hstep, voffB); PG8_STAGEA(PG8_SA(1, 0), a3, 0);
            PG8_WAIT_V(8); PG8_WAIT_L(0); PG8_BAR; PG8_MMA(1, 0, At, B0); PG8_MMA(1, 1, At, B1); PG8_BAR; PG8_SCHED;
            } else {
            PG8_LDB(B0, 0, 0); PG8_SCHED; PG8_LDA(At, 0, 0); PG8_STAGE(PG8_SA(1, 1), a1 + hstep, voffA);
            PG8_WAIT_L(8); PG8_BAR; PG8_WAIT_L(0); PG8_MMA(0, 0, At, B0); PG8_BAR; PG8_SCHED;
            PG8_LDB(B1, 0, 1); PG8_STAGE(PG8_SB(0, 0), b2, voffB);
            PG8_BAR; PG8_WAIT_L(0); PG8_MMA(0, 1, At, B1); PG8_BAR;
            PG8_LDA(At, 0, 1); PG8_STAGE(PG8_SA(0, 0), a2, voffA);
            PG8_BAR; PG8_WAIT_L(0); PG8_MMA(1, 0, At, B0); PG8_BAR; PG8_SCHED;
            PG8_STAGE(PG8_SB(0, 1), b2 + hstep, voffB);
            PG8_WAIT_V(6); PG8_BAR; PG8_MMA(1, 1, At, B1); PG8_BAR;
            PG8_LDB(B0, 1, 0); PG8_SCHED; PG8_LDA(At, 1, 0); PG8_STAGE(PG8_SA(0, 1), a2 + hstep, voffA);
            PG8_WAIT_L(8); PG8_BAR; PG8_WAIT_L(0); PG8_MMA(0, 0, At, B0); PG8_BAR; PG8_SCHED;
            PG8_LDB(B1, 1, 1); PG8_STAGE(PG8_SB(1, 0), b3, voffB);
            PG8_BAR; PG8_WAIT_L(0); PG8_MMA(0, 1, At, B1); PG8_BAR;
            PG8_LDA(At, 1, 1); PG8_STAGE(PG8_SA(1, 0), a3, voffA);
            PG8_BAR; PG8_WAIT_L(0); PG8_MMA(1, 0, At, B0); PG8_BAR; PG8_SCHED;
            PG8_STAGE(PG8_SB(1, 1), b3 + hstep, voffB);
            PG8_WAIT_V(6); PG8_BAR; PG8_MMA(1, 1, At, B1); PG8_BAR;
            }
        }
        if constexpr (ALIGN_EPI) { if (wr == 0) PG8_BAR; }
        if constexpr (!Epi::AFTER_DRAIN) { int t2_ = threadIdx.x; asm volatile("" : "+v"(t2_)); const int fr_ = t2_ & 15, fq_ = (t2_ >> 4) & 3;
            E(acc, cur, wr, wc, fr_, fq_); S.done(cur); }
        if (!has_next) break;
#pragma unroll
        for (int a = 0; a < 2; ++a)
#pragma unroll
            for (int b = 0; b < 2; ++b)
#pragma unroll
                for (int m = 0; m < 4; ++m)
#pragma unroll
                    for (int n = 0; n < 2; ++n) acc[a][b][m][n] = (f32x4){0.f, 0.f, 0.f, 0.f};
        cur = nxt; cA = nA; cB = nB; ++ui;
        if constexpr (ALIGN_EPI) { if (wr == 1) PG8_BAR; }
    }
    PG8_WAIT_V(0);
    if constexpr (!ALIGN_EPI) { if (wr == 0) PG8_BAR; }
    PG8_BAR;
    if constexpr (Epi::AFTER_DRAIN) { E.fused(acc, cur, wr, wc, fr, fq, lds, wid, lane); S.done(cur); }
#undef PG8_SA
#undef PG8_SB
#undef PG8_STAGE
#undef PG8_STAGEA
#undef PG8_LOADG
#undef PG8_LDA
#undef PG8_LDB
#undef PG8_MMA
#undef PG8_WAIT_V
#undef PG8_WAIT_L
#undef PG8_BAR
#undef PG8_SCHED
}
}

#ifndef PG8_SP2
#define PG8_SP2 true
#endif
#ifndef PG8_ALIGN
#define PG8_ALIGN true
#endif

constexpr int NWAVES = 8, NTHR = 512;
constexpr int BATCH = 2, SEQ = 8192, M = BATCH * SEQ, D = 1024, DEPTH = 2;
constexpr int NIN = 2688, NINP = 2816;
constexpr int RW_R0 = 0, RW_K0 = 512, RW_V0 = 1024, RW_WD0 = 1536, RW_AD0 = 1600, RW_GD0 = 1664, RW_IN = 1824;
constexpr int ML_CQ0 = 1824, ML_CKV0 = 2016, ML_KR0 = 2144;
constexpr int GM_U0 = 2176, GM_V0 = 2432;
constexpr int MIX_MLA0 = 512, MIX_GM0 = 768;
constexpr int NEXP = 32, PROWS = 40960;
constexpr float EPS = 1e-6f, GN_EPS = 64e-5f;

constexpr size_t MiB = 1u << 20;
constexpr size_t WS_CTL = 0, CTL_ZERO_BYTES = 1 * MiB;
constexpr size_t WS_MKV = 1 * MiB;
constexpr size_t WS_WRT = 3 * MiB;
constexpr int RW_KS = 1152;
constexpr size_t WS_MN = 4 * MiB;
constexpr size_t WS_WIN = 5 * MiB, WS_WOUT = 16 * MiB, WS_WMQ = 20 * MiB, WS_WMO = 21 * MiB, WS_WMKV = 22 * MiB;
constexpr size_t WS_W13 = 23 * MiB, WS_W2 = 151 * MiB;
constexpr size_t WS_XN = 215 * MiB, WS_MIX = 247 * MiB, WS_Q2 = 279 * MiB, WS_O2 = 287 * MiB;
constexpr size_t WS_PROJ = 295 * MiB, WS_RWA = 383 * MiB, WS_RWG = 399 * MiB, WS_RWD = 415 * MiB, WS_MQ = 447 * MiB, WS_MK = 459 * MiB, WS_MV = 471 * MiB;
constexpr size_t WS_HS = 295 * MiB, WS_H = 375 * MiB, WS_YM = 415 * MiB;
constexpr size_t WS_END = 479 * MiB;
constexpr size_t WS_LIST = WS_HS, WS_LISTG = WS_HS + 2 * MiB;
constexpr size_t WS_GWS = 2 * MiB + 640 * 1024;

constexpr size_t WS_MLAW = 511 * MiB;
constexpr int MLAW_L = 384 * 192 + 512 * 128;

constexpr size_t WS_LORA = 3 * MiB + 320 * 1024;
constexpr int LORA_L = 512 * 64 * 2 + 512 * 160, ACTP = 304;

static_assert(WS_HS + (size_t)PROWS * 1024 * 2 <= WS_H && WS_H + (size_t)PROWS * 512 * 2 <= WS_YM && WS_YM + (size_t)32768 * 1024 * 2 <= WS_END, "moe map");
constexpr int CW_BAR = 4096;
constexpr int CW_RSS = 65536;
constexpr int CW_CNT = 16384, CW_CUR = 16384 + 4096;
constexpr int CW_XC = 131072;
constexpr int CW_MD = 98304;
constexpr int GT_OFF = 131072, GT_UNITS = 4;
constexpr int RING_BYTES = 159744, LDSCTL_OFF = RING_BYTES, MISC_OFF = LDSCTL_OFF + 320, TBL_OFF = LDSCTL_OFF + 1024, LDS_BYTES = 163840;

#define GAS __attribute__((address_space(1)))
#define LAS __attribute__((address_space(3)))
typedef unsigned short bf16;
typedef unsigned v4u __attribute__((ext_vector_type(4)));
typedef unsigned v2u __attribute__((ext_vector_type(2)));
typedef float f32x4 __attribute__((ext_vector_type(4)));
#define LDS_WAIT() asm volatile("s_waitcnt lgkmcnt(0)" ::: "memory")
typedef float f32x2_t __attribute__((ext_vector_type(2)));
typedef __bf16 bf16x2_t __attribute__((ext_vector_type(2)));
__device__ __forceinline__ unsigned pk2(float lo, float hi) { const f32x2_t v = {lo, hi}; const bf16x2_t b = __builtin_convertvector(v, bf16x2_t); return __builtin_bit_cast(unsigned, b); }
__device__ __forceinline__ unsigned f2bf(float f) { return pk2(f, f) & 0xffffu; }
__device__ __forceinline__ float bf2f(unsigned b) { return __builtin_bit_cast(float, b << 16); }
__device__ __forceinline__ float bflo(unsigned w) { return __builtin_bit_cast(float, w << 16); }
__device__ __forceinline__ float bfhi(unsigned w) { return __builtin_bit_cast(float, w & 0xffff0000u); }
__device__ __forceinline__ float sigmoidf_(float x) { return __builtin_amdgcn_rcpf(1.0f + __expf(-x)); }
__device__ __forceinline__ float tanhf_(float x) { return 1.0f - 2.0f * __builtin_amdgcn_rcpf(1.0f + __expf(2.0f * x)); }
__device__ __forceinline__ float gelu_tanh(float x) { return x * sigmoidf_(1.5957691216057308f * (x + 0.044715f * x * x * x)); }
__device__ __forceinline__ float shx(float v, int o) {
    const int x = __builtin_bit_cast(int, v); int r;
    if (o == 1) r = __builtin_amdgcn_mov_dpp(x, 0xB1, 0xF, 0xF, true);
    else if (o == 2) r = __builtin_amdgcn_mov_dpp(x, 0x4E, 0xF, 0xF, true);
    else if (o == 4) r = __builtin_amdgcn_ds_swizzle(x, 0x101F);
    else if (o == 8) r = __builtin_amdgcn_ds_swizzle(x, 0x201F);
    else if (o == 16) r = __builtin_amdgcn_ds_swizzle(x, 0x401F);
    else { const auto p = __builtin_amdgcn_permlane32_swap((unsigned)x, (unsigned)x, false, false); r = (int)((threadIdx.x & 32u) ? p[0] : p[1]); }
    return __builtin_bit_cast(float, r);
}
__device__ __forceinline__ float wave_sum(float v) {
#pragma unroll
    for (int o = 1; o < 64; o <<= 1) v += shx(v, o);
    return v;
}

#define XB_TMO      128
#define XB_XCNT(j)  (256  + 64 * (j))
#define XB_XSUB(j)  (1280 + 64 * (j))
#define XB_XGEN(j)  (2304 + 64 * (j))
#define XB_TOP      3328
#define XB_TOPGEN   3392
#define XCD_BAR_WORDS 3456
#define XB_SPIN_CAP (1u << 23)
__device__ __forceinline__ unsigned xb_ld(unsigned* p)              { return __hip_atomic_load(p, __ATOMIC_RELAXED, __HIP_MEMORY_SCOPE_AGENT); }
__device__ __forceinline__ unsigned xb_add(unsigned* p, unsigned v) { return __hip_atomic_fetch_add(p, v, __ATOMIC_RELAXED, __HIP_MEMORY_SCOPE_AGENT); }
__device__ __forceinline__ unsigned xb_xcc_id() { return (unsigned)__builtin_amdgcn_s_getreg((3 << 11) | 20) & 0xFu; }
#define XB_SPIN(cond, bar) do { unsigned _sp = 0; while (cond) { __builtin_amdgcn_s_sleep(1); \
    if ((++_sp & 255u) == 0u) { if (xb_ld(&(bar)[XB_TMO])) break; if (_sp > XB_SPIN_CAP) { atomicAdd(&(bar)[XB_TMO], 1u); break; } } } } while (0)
struct XcdBarrier { unsigned* bar; unsigned x; volatile LAS unsigned* st; };
__device__ __forceinline__ XcdBarrier xcd_barrier_post(unsigned* bar, volatile LAS unsigned* st) {
    XcdBarrier b; b.bar = bar; b.x = xb_xcc_id(); b.st = st;
    if (threadIdx.x == 0) st[3] = xb_add(&bar[XB_XCNT(b.x)], 1u);
    return b;
}
__device__ __forceinline__ void xcd_barrier_complete(unsigned* bar, unsigned x, unsigned& nloc, unsigned& nx, unsigned& xi) {
    const unsigned G = gridDim.x * gridDim.y * gridDim.z;
    unsigned sum, cnt, mine, before, sp = 0u;
    for (;;) {
        sum = 0u; cnt = 0u; mine = 0u; before = 0u;
#pragma unroll
        for (unsigned j = 0; j < 16; ++j) { const unsigned c = xb_ld(&bar[XB_XCNT(j)]); sum += c; cnt += (c > 0u) ? 1u : 0u; mine = (j == x) ? c : mine; before += (j < x && c > 0u) ? 1u : 0u; }
        if (sum == G) break;
        __builtin_amdgcn_s_sleep(1);
        if ((++sp & 255u) == 0u) { if (xb_ld(&bar[XB_TMO])) break; if (sp > XB_SPIN_CAP) { atomicAdd(&bar[XB_TMO], 1u); break; } }
    }
    nloc = mine > 0u ? mine : 1u; nx = cnt > 0u ? cnt : 1u; xi = before;
}
template <bool LIGHT = false> __device__ __forceinline__ void xcd_barrier(const XcdBarrier& b) {
    asm volatile("s_waitcnt vmcnt(0)" ::: "memory");
    __syncthreads();
    if (threadIdx.x == 0) {
        unsigned* bar = b.bar;
        __builtin_amdgcn_s_waitcnt(0);
        unsigned nloc = b.st[0], nx = b.st[1];
        if (nloc == 0u) { unsigned xi; xcd_barrier_complete(bar, b.x, nloc, nx, xi); b.st[0] = nloc; b.st[1] = nx; b.st[2] = xi; }
        const unsigned old = xb_add(&bar[XB_XSUB(b.x)], 1u);
        const unsigned gen = old / nloc;
        if (old + 1u == (gen + 1u) * nloc) {
            if constexpr (!LIGHT) __builtin_amdgcn_fence(__ATOMIC_RELEASE, "agent");
            asm volatile("s_waitcnt vmcnt(0)" ::: "memory");
            const unsigned og = xb_add(&bar[XB_TOP], 1u);
            const unsigned tg = og / nx;
            if (og + 1u == (tg + 1u) * nx) xb_add(&bar[XB_TOPGEN], 1u);
            else XB_SPIN(xb_ld(&bar[XB_TOPGEN]) == tg, bar);
            if constexpr (!LIGHT) __builtin_amdgcn_fence(__ATOMIC_ACQUIRE, "agent");
            xb_add(&bar[XB_XGEN(b.x)], 1u);
            asm volatile("s_waitcnt vmcnt(0)" ::: "memory");
        } else {
            XB_SPIN(xb_ld(&bar[XB_XGEN(b.x)]) == gen, bar);
            if constexpr (!LIGHT) __builtin_amdgcn_fence(__ATOMIC_ACQUIRE, "agent");
            asm volatile("s_waitcnt vmcnt(0)" ::: "memory");
        }
    }
    __syncthreads();
}

struct Args { const void* in[41]; float* out; unsigned char* ws; int ph_lo, ph_hi; };
struct Frame {
    LAS unsigned char* lds; volatile LAS unsigned* MISC; GAS unsigned* ctl;
    int tid, lane, wave, bid, G;
    GAS unsigned char* ws; GAS float* out;
};

struct XDeal { int rt0, U, rank, nloc; };
__device__ __forceinline__ void xd_wait(unsigned* c, unsigned target = 32u) { unsigned sp = 0u;
    while (__hip_atomic_load(c, __ATOMIC_RELAXED, __HIP_MEMORY_SCOPE_AGENT) < target) { __builtin_amdgcn_s_sleep(2); if (++sp > (1u << 22)) break; }
    asm volatile("" ::: "memory"); }
__device__ __forceinline__ void xd_signal(unsigned* c) { asm volatile("s_waitcnt vmcnt(0)" ::: "memory");
    if ((threadIdx.x & 63) == 0) __hip_atomic_fetch_add(c, 1u, __ATOMIC_RELAXED, __HIP_MEMORY_SCOPE_AGENT); }

__device__ __forceinline__ void xd_block_done(unsigned* c) { if (threadIdx.x == 0) __hip_atomic_fetch_add(c, 1u, __ATOMIC_RELAXED, __HIP_MEMORY_SCOPE_AGENT); }
__device__ __forceinline__ void xd_wait_blocks(unsigned* c, unsigned target) {
    if (threadIdx.x == 0) { unsigned sp = 0u; while (__hip_atomic_load(c, __ATOMIC_RELAXED, __HIP_MEMORY_SCOPE_AGENT) < target) { __builtin_amdgcn_s_sleep(8); if (++sp > (1u << 21)) break; } }
    __syncthreads(); }

__device__ __forceinline__ bool xd_wait_proj(const XDeal& xd, unsigned* c1, int tile) {
    const int R = tile >> 2;
    xd_wait(c1 + R * 64, 88u);
    if ((tile & 3) == 0 && ((tile * 64) & (SEQ - 1)) != 0) { xd_wait(c1 + (R - 1) * 64, 88u); return R == xd.rt0; }
    return false;
}
__device__ __forceinline__ unsigned ld_bf16_dev(const bf16* p) {
    const unsigned long long a = (unsigned long long)p; const unsigned w = __hip_atomic_load((const unsigned*)(a & ~3ull), __ATOMIC_RELAXED, __HIP_MEMORY_SCOPE_AGENT);
    return (a & 2ull) ? (w >> 16) : (w & 0xffffu);
}

__device__ __forceinline__ void transpose_item(const float* W, int K, int N, bf16* WT, int rmul, int radd, LAS float* scr, int item, int lane, const float* gk = nullptr, const bool nts = false) {
    const int nblk = N / 32, kb = item / nblk, nb = item % nblk, k0 = 64 * kb, n0 = 32 * nb;
#pragma unroll 8
    for (int i = 0; i < 32; ++i) { const int kk = 2 * i + (lane >> 5); scr[kk * 33 + (lane & 31)] = __builtin_nontemporal_load(W + (size_t)(k0 + kk) * N + n0 + (lane & 31)) * (gk ? gk[k0 + kk] : 1.0f); }
    LDS_WAIT(); asm volatile("" ::: "memory");
    const int c = lane & 7;
    const int rbase = (n0 / 128) * rmul + (n0 % 128) + radd;
#pragma unroll
    for (int j = 0; j < 4; ++j) { const int n = (lane >> 3) + 8 * j; const LAS float* s = scr + (8 * c) * 33 + n;
        v4u o; o.x = pk2(s[0 * 33], s[1 * 33]); o.y = pk2(s[2 * 33], s[3 * 33]); o.z = pk2(s[4 * 33], s[5 * 33]); o.w = pk2(s[6 * 33], s[7 * 33]);
        if (nts) __builtin_nontemporal_store(o, (v4u*)(WT + (size_t)(rbase + n) * K + k0 + 8 * c)); else *(v4u*)(WT + (size_t)(rbase + n) * K + k0 + 8 * c) = o; }
    LDS_WAIT(); asm volatile("" ::: "memory");
}

__device__ __forceinline__ float norm_row(int lane, const float* xin, float* xout, const bf16* y0, const bf16* y1, const float* g, bf16* xn, f32x4 (&hv)[4]) {
    float ss = 0.f;
#pragma unroll
    for (int j = 0; j < 4; ++j) {
        f32x4 v = *(const f32x4*)(xin + 4 * lane + 256 * j);
        if (y0) { const v2u a = *(const v2u*)(y0 + 4 * lane + 256 * j), b = *(const v2u*)(y1 + 4 * lane + 256 * j);
            v.x += bflo(a.x) + bflo(b.x); v.y += bfhi(a.x) + bfhi(b.x); v.z += bflo(a.y) + bflo(b.y); v.w += bfhi(a.y) + bfhi(b.y); }
        if (xout) *(f32x4*)(xout + 4 * lane + 256 * j) = v;
        hv[j] = v; ss += (v.x * v.x + v.y * v.y) + (v.z * v.z + v.w * v.w);
    }
    const float rstd = rsqrtf(wave_sum(ss) * (1.0f / 1024.0f) + EPS);
#pragma unroll
    for (int j = 0; j < 4; ++j) { const f32x4 gg = g ? *(const f32x4*)(g + 4 * lane + 256 * j) : (f32x4){1.f, 1.f, 1.f, 1.f}; hv[j] = hv[j] * rstd * gg;
        if (xn) { v2u o; o.x = pk2(hv[j].x, hv[j].y); o.y = pk2(hv[j].z, hv[j].w); *(v2u*)(xn + 4 * lane + 256 * j) = o; } }
    return rstd;
}

__device__ __forceinline__ void p0_prologue(Frame& F, const Args& A) {
    LAS float* scr = (LAS float*)(F.lds + F.wave * 16384);
    const int gw = F.bid * NWAVES + F.wave, NGW = F.G * NWAVES;
    bf16* ws16 = (bf16*)F.ws;
    constexpr int I_IN = 16 * (NIN / 32), I_OUT = 16 * 32, I_MQ = 16 * 8, I_MO = 4 * 32, I_MKV = 16 * 16, I_W1 = 16 * 16, I_W2 = 8 * 32;
    constexpr int I_MOE = 2 * I_W1 + I_W2;
    constexpr int NITEMS = DEPTH * (I_IN + I_OUT + I_MQ + I_MO) + I_MKV + DEPTH * NEXP * I_MOE;
#pragma unroll 1
    for (int it = gw; it < NITEMS; it += NGW) {
        int r = it;
        if (r < DEPTH * I_IN) { const int l = r / I_IN; r %= I_IN; transpose_item((const float*)A.in[4] + (size_t)l * D * NIN, D, NIN, (bf16*)(F.ws + WS_WIN) + (size_t)l * NINP * D, 128, 0, scr, r, F.lane); continue; } r -= DEPTH * I_IN;
        if (r < DEPTH * I_OUT) { const int l = r / I_OUT; r %= I_OUT; transpose_item((const float*)A.in[25] + (size_t)l * D * D, D, D, (bf16*)(F.ws + WS_WOUT) + (size_t)l * D * D, 128, 0, scr, r, F.lane); continue; } r -= DEPTH * I_OUT;
        if (r < DEPTH * I_MQ) { const int l = r / I_MQ; r %= I_MQ; transpose_item((const float*)A.in[30] + (size_t)l * D * 256, D, 256, (bf16*)(F.ws + WS_WMQ) + (size_t)l * 256 * D, 128, 0, scr, r, F.lane, (const float*)A.in[29] + l * D); continue; } r -= DEPTH * I_MQ;
        if (r < DEPTH * I_MO) { const int l = r / I_MO; r %= I_MO; transpose_item((const float*)A.in[32] + (size_t)l * 256 * D, 256, D, (bf16*)(F.ws + WS_WMO) + (size_t)l * D * 256, 128, 0, scr, r, F.lane); continue; } r -= DEPTH * I_MO;
        if (r < I_MKV) { transpose_item((const float*)A.in[27], D, 512, (bf16*)(F.ws + WS_WMKV), 128, 0, scr, r, F.lane); continue; } r -= I_MKV;
        { const int le = r / I_MOE; r %= I_MOE;
          if (r < I_W1) { transpose_item((const float*)A.in[38] + (size_t)le * D * 512, D, 512, (bf16*)(F.ws + WS_W13) + (size_t)le * 1024 * D, 256, 0, scr, r, F.lane, nullptr, true); continue; } r -= I_W1;
          if (r < I_W1) { transpose_item((const float*)A.in[39] + (size_t)le * D * 512, D, 512, (bf16*)(F.ws + WS_W13) + (size_t)le * 1024 * D, 256, 128, scr, r, F.lane, nullptr, true); continue; } r -= I_W1;
          transpose_item((const float*)A.in[40] + (size_t)le * 512 * D, 512, D, (bf16*)(F.ws + WS_W2) + (size_t)le * D * 512, 128, 0, scr, r, F.lane, nullptr, true); }
    }
    { const int gt = F.bid * NTHR + F.tid, NGT = F.G * NTHR;
#pragma clang loop vectorize(disable) interleave(disable) unroll(disable)
      for (int i = gt; i < DEPTH * 128 * (D / 8); i += NGT) { const int l = i / (128 * (D / 8)), rr = i % (128 * (D / 8));
          *(v4u*)((bf16*)(F.ws + WS_WIN) + (size_t)l * NINP * D + (size_t)NIN * D + (size_t)rr * 8) = (v4u){0u, 0u, 0u, 0u}; }
      bf16* wrf = (bf16*)(F.ws + WS_WRT);
#pragma clang loop vectorize(disable) interleave(disable) unroll(disable)
      for (int i = gt; i < DEPTH * 2 * 32 * RW_KS; i += NGT) { const int l = i / (2 * 32 * RW_KS), part = (i / (32 * RW_KS)) & 1, ks = (i / RW_KS) & 31, q = i % RW_KS;
          int j, kq; const int e = q & 7;
          if (q < 1024) { const int t = q >> 9, ln = (q >> 3) & 63; j = 16 * t + (ln & 15); kq = ln >> 4; } else { const int sl = (q - 1024) >> 3; j = 32 + (sl & 3); kq = sl >> 2; }
          const int c = 32 * ks + 8 * kq + e;
          const float wv = ((j < 4) ? ((const float*)A.in[34])[(size_t)l * 1024 * 4 + c * 4 + j] : ((const float*)A.in[36])[(size_t)l * 1024 * 32 + c * 32 + (j - 4)]) * ((const float*)A.in[33])[l * D + c];
          const unsigned short hi = f2bf(wv); const float hf = __builtin_bit_cast(float, (unsigned)hi << 16);
          wrf[i] = (bf16)(part ? f2bf(wv - hf) : hi); }
    }
    { const int gt = F.bid * NTHR + F.tid, NGT = F.G * NTHR; bf16* lw_ = (bf16*)(F.ws + WS_LORA);
#pragma clang loop vectorize(disable) interleave(disable) unroll(disable)
      for (int i = gt; i < DEPTH * LORA_L; i += NGT) { const int l = i / LORA_L, r = i % LORA_L; float v;
          if (r < 512 * 64) v = ((const float*)A.in[7])[(size_t)l * 64 * 512 + (r % 64) * 512 + r / 64];
          else if (r < 2 * 512 * 64) { const int q = r - 512 * 64; v = ((const float*)A.in[9])[(size_t)l * 64 * 512 + (q % 64) * 512 + q / 64]; }
          else { const int q = r - 2 * 512 * 64; v = ((const float*)A.in[10])[(size_t)l * 160 * 512 + (q % 160) * 512 + q / 160]; }
          lw_[i] = (bf16)f2bf(v); } }
    { const int gt = F.bid * NTHR + F.tid, NGT = F.G * NTHR; bf16* mw_ = (bf16*)(F.ws + WS_MLAW);
#pragma clang loop vectorize(disable) interleave(disable) unroll(disable)
      for (int i = gt; i < DEPTH * MLAW_L; i += NGT) { const int l = i / MLAW_L, r = i % MLAW_L; float v;
          if (r < 384 * 192) v = ((const float*)A.in[17])[(size_t)l * 192 * 384 + (r % 192) * 384 + r / 192];
          else { const int q = r - 384 * 192; v = ((const float*)A.in[19])[(size_t)l * 128 * 512 + (q % 128) * 512 + q / 128]; }
          mw_[i] = (bf16)f2bf(v); } }
    { const int gt = F.bid * NTHR + F.tid, NGT = F.G * NTHR; bf16* gw_ = (bf16*)(F.ws + WS_GWS);
#pragma clang loop vectorize(disable) interleave(disable) unroll(disable)
      for (int i = gt; i < DEPTH * 4 * 16384; i += NGT) { const int tt_ = (i >> 7) & 127, ss_ = i & 127; gw_[i] = (bf16)f2bf(ss_ <= tt_ ? ((const float*)A.in[23])[i] : 0.f); } }
    f32x4 hv[4];
#pragma unroll 1
    for (int m = gw; m < 512; m += NGW) norm_row(F.lane, (const float*)A.in[1] + (size_t)m * D, nullptr, nullptr, nullptr, (const float*)A.in[26], (bf16*)(F.ws + WS_MN) + (size_t)m * D, hv);
#pragma unroll 1
    for (int m = gw; m < M; m += NGW) norm_row(F.lane, (const float*)A.in[0] + (size_t)m * D, nullptr, nullptr, nullptr, (const float*)A.in[3], (bf16*)(F.ws + WS_XN) + (size_t)m * D, hv);
    (void)ws16;
}

typedef short bf16x8 __attribute__((ext_vector_type(8)));
constexpr int CP = 64;
constexpr int CMAT = 64 * CP * 2;
__device__ __forceinline__ int cko(int row, int col) { return row * CP + ((((col >> 3) ^ (row >> 1)) & 7) << 3) + (col & 7); }
constexpr int CK_AT = 0, CK_BT = 1, CK_KT = 2, CK_RT = 3, CK_ATT = 4, CK_BHT = 5, CK_KHT = 6, CK_VT = 7, CK_AAK = 8, CK_ABRT = 9, CK_AKRT = 10;
constexpr int CK_SET0 = 11, CK_SET1 = 14;
constexpr int CK_GSUM_OFF = 17 * CMAT;
constexpr int CK_WC_OFF = CK_GSUM_OFF + 8 * 64 * 4;
static_assert(CK_WC_OFF + 256 <= RING_BYTES, "chunk prep LDS");
constexpr size_t WS_PT = WS_XN + 16 * MiB, WS_QB = WS_Q2, WS_S0 = 479 * MiB, WS_YL = 495 * MiB;
__device__ __forceinline__ size_t yrt_off(int tile, int h, int blk) { return ((size_t)(tile * 64 + h * 8 + blk)) * 1024; }
static_assert(WS_YL + 16 * MiB <= (size_t)512 * MiB, "ws map");

__device__ __forceinline__ f32x4 ck_tile(const LAS bf16* L, const LAS bf16* R, int n0, int m0, int lane) {
    const int r = lane & 15, kq = lane >> 4;
    f32x4 acc = (f32x4){0.f, 0.f, 0.f, 0.f};
#pragma unroll
    for (int ks = 0; ks < 2; ++ks) {
        const bf16x8 a = *(const LAS bf16x8*)(R + (m0 + r) * CP + ks * 32 + kq * 8);
        const bf16x8 b = *(const LAS bf16x8*)(L + (n0 + r) * CP + ks * 32 + kq * 8);
        acc = __builtin_amdgcn_mfma_f32_16x16x32_bf16(a, b, acc, 0, 0, 0);
    }
    return acc;
}
__device__ __forceinline__ v2u pack4(f32x4 v) { v2u o; o.x = pk2(v.x, v.y); o.y = pk2(v.z, v.w); return o; }
__device__ __forceinline__ f32x4 unpack4(v2u w) { return (f32x4){bflo(w.x), bfhi(w.x), bflo(w.y), bfhi(w.y)}; }

#define CK_RAWLOAD(hh_) do { const int c_ = (hh_) * 64 + (F.tid & 63); const int mf_ = tile * 64 + 8 * (F.tid >> 6); const bf16* P_ = (const bf16*)(F.ws + WS_PROJ); \
        if ((mf_ & (SEQ - 1)) == 0) { qp[0] = 0u; qp[1] = 0u; qp[2] = 0u; } else { const bf16* pp_ = P_ + (size_t)(mf_ - 1) * NINP; if (coh && (F.tid >> 6) == 0) { qp[0] = ld_bf16_dev(pp_ + RW_R0 + c_); qp[1] = ld_bf16_dev(pp_ + RW_K0 + c_); qp[2] = ld_bf16_dev(pp_ + RW_V0 + c_); } else { qp[0] = pp_[RW_R0 + c_]; qp[1] = pp_[RW_K0 + c_]; qp[2] = pp_[RW_V0 + c_]; } } \
        _Pragma("unroll") for (int i_ = 0; i_ < 8; ++i_) { const size_t m_ = (size_t)(mf_ + i_); const bf16* pp_ = P_ + m_ * NINP; qr[i_] = pp_[RW_R0 + c_]; qk[i_] = pp_[RW_K0 + c_]; qv[i_] = pp_[RW_V0 + c_]; \
            qw[i_] = ((const float*)(F.ws + WS_RWD))[m_ * 512 + c_]; qa[i_] = ((const bf16*)(F.ws + WS_RWA))[m_ * 512 + c_]; } } while (0)
__device__ __forceinline__ void chunk_prep_item(Frame& F, const Args& A, int l, int tile, int h, const bool coh, unsigned (&qr)[8], unsigned (&qk)[8], unsigned (&qv)[8], unsigned (&qa)[8], float (&qw)[8], unsigned (&qp)[3]) {
    LAS bf16* MT = (LAS bf16*)F.lds;
#define CKM(s) (MT + (s) * 64 * CP)
    LAS float* gsum = (LAS float*)(F.lds + CK_GSUM_OFF);
    LAS float* WCs = (LAS float*)(F.lds + CK_WC_OFF);
    const bf16* P = (const bf16*)(F.ws + WS_PROJ); const float* RWD = (const float*)(F.ws + WS_RWD); const bf16* RWA = (const bf16*)(F.ws + WS_RWA);
    const float* mu = (const float*)A.in[5] + l * RW_IN;
    const int ci = tile * 8 + h; const int m0 = tile * 64;
    bf16* YLg = (bf16*)(F.ws + WS_YL) + (size_t)ci * 4096;
    bf16* PTg = (bf16*)(F.ws + WS_PT) + (size_t)ci * 4096; bf16* QBg = (bf16*)(F.ws + WS_QB) + (size_t)ci * 4096; bf16* YRm = (bf16*)(F.ws + WS_MIX);
    const int ch = F.tid & 63, tg = F.tid >> 6;
    __syncthreads();
    {
        const int c = h * 64 + ch;
        const float mur = mu[RW_R0 + c], muk = mu[RW_K0 + c], muv = mu[RW_V0 + c];
        const float kkw = ((const float*)A.in[11])[l * 512 + c], kaw = ((const float*)A.in[12])[l * 512 + c];
        float rs[8], ks[8], vs[8], lw[8], al[8];
        const int mfirst = m0 + 8 * tg;
        float pr = bf2f(qp[0]), pk = bf2f(qp[1]), pv = bf2f(qp[2]);
#pragma unroll
        for (int i = 0; i < 8; ++i) {
            const float cr = bf2f(qr[i]), ck = bf2f(qk[i]), cv = bf2f(qv[i]);
            rs[i] = cr + (pr - cr) * mur; ks[i] = ck + (pk - ck) * muk; vs[i] = cv + (pv - cv) * muv; pr = cr; pk = ck; pv = cv;
            lw[i] = qw[i]; al[i] = bf2f(qa[i]); }
        (void)mfirst; (void)P; (void)RWD; (void)RWA;
        if (h < 7) CK_RAWLOAD(h + 1);
        float cum[8]; { float s = 0.f;
#pragma unroll
            for (int i = 0; i < 8; ++i) { s += lw[i]; cum[i] = s; }
            gsum[tg * 64 + ch] = s; }
        float kk[8];
#pragma unroll
        for (int i = 0; i < 8; ++i) { const float kv = ks[i] * kkw; const float n2 = wave_sum(kv * kv); kk[i] = kv / fmaxf(sqrtf(n2), 1e-12f); }
        __syncthreads();
        float off = 0.f, tot = 0.f;
#pragma unroll
        for (int g = 0; g < 8; ++g) { const float s = gsum[g * 64 + ch]; off += (g < tg) ? s : 0.f; tot += s; }
        if (tg == 0) WCs[ch] = __expf(tot);
        v4u wa, wb, wk, wv; unsigned ua[8], ub[8], uk[8], uv[8];
#pragma unroll
        for (int i = 0; i < 8; ++i) { const int t = 8 * tg + i; const float cu = off + cum[i];
            const float Wt = __expf(cu), Wi = __expf(-cu), Wp = __expf(cu - lw[i]), Wc = __expf(tot - cu);
            const float k2 = ks[i] * (1.0f + (al[i] - 1.0f) * kaw), bv = kk[i] * al[i];
            const unsigned at = f2bf(-kk[i] * Wp);
            const int to_ = cko(t, ch); CKM(CK_AT)[to_] = (bf16)at; CKM(CK_RT)[to_] = (bf16)f2bf(rs[i] * Wt); CKM(CK_BT)[to_] = (bf16)f2bf(bv * Wi); CKM(CK_KT)[to_] = (bf16)f2bf(k2 * Wi);
            ua[i] = at; ub[i] = f2bf(bv * Wc); uk[i] = f2bf(k2 * Wc); uv[i] = f2bf(vs[i]); }
        wa.x = ua[0] | (ua[1] << 16); wa.y = ua[2] | (ua[3] << 16); wa.z = ua[4] | (ua[5] << 16); wa.w = ua[6] | (ua[7] << 16);
        wb.x = ub[0] | (ub[1] << 16); wb.y = ub[2] | (ub[3] << 16); wb.z = ub[4] | (ub[5] << 16); wb.w = ub[6] | (ub[7] << 16);
        wk.x = uk[0] | (uk[1] << 16); wk.y = uk[2] | (uk[3] << 16); wk.z = uk[4] | (uk[5] << 16); wk.w = uk[6] | (uk[7] << 16);
        wv.x = uv[0] | (uv[1] << 16); wv.y = uv[2] | (uv[3] << 16); wv.z = uv[4] | (uv[5] << 16); wv.w = uv[6] | (uv[7] << 16);
        const int co_ = cko(ch, 8 * tg); *(LAS v4u*)(CKM(CK_ATT) + co_) = wa; *(LAS v4u*)(CKM(CK_BHT) + co_) = wb; *(LAS v4u*)(CKM(CK_KHT) + co_) = wk; *(LAS v4u*)(CKM(CK_VT) + co_) = wv;
    }
    __syncthreads();
    const int w = F.wave, lane = F.lane, nt = w & 3, mtb = (w >> 2) * 2;
    const int nn = 16 * nt + (lane & 15);
#define CKF(dst, slot, row0) do { const LAS bf16* p_ = CKM(slot) + (row0) * CP; dst[0] = *(const LAS bf16x8*)(p_ + cf0); dst[1] = *(const LAS bf16x8*)(p_ + cf1); } while (0)
#define CKMMA(Lf, Rf) __builtin_amdgcn_mfma_f32_16x16x32_bf16(Rf[1], Lf[1], __builtin_amdgcn_mfma_f32_16x16x32_bf16(Rf[0], Lf[0], (f32x4){0.f, 0.f, 0.f, 0.f}, 0, 0, 0), 0, 0, 0)
    const int n0 = 16 * nt, mq = 4 * (lane >> 4);
    const int cf0 = cko(lane & 15, (lane >> 4) * 8), cf1 = cko(lane & 15, 32 + (lane >> 4) * 8);
    const int so[2] = {cko(nn, 16 * mtb + mq), cko(nn, 16 * (mtb + 1) + mq)};
    {
        bf16x8 atn[2], btn[2], ktn[2], rtn[2], atm[2][2], btm[2][2], ktm[2][2];
        CKF(atn, CK_AT, n0); CKF(btn, CK_BT, n0); CKF(ktn, CK_KT, n0); CKF(rtn, CK_RT, n0);
#pragma unroll
        for (int mi = 0; mi < 2; ++mi) { CKF(atm[mi], CK_AT, 16 * (mtb + mi)); CKF(btm[mi], CK_BT, 16 * (mtb + mi)); CKF(ktm[mi], CK_KT, 16 * (mtb + mi)); }
        f32x4 r0[2], r1[2], r2[2], r3[2], r4[2];
#pragma unroll
        for (int mi = 0; mi < 2; ++mi) { r0[mi] = CKMMA(atn, btm[mi]); r1[mi] = CKMMA(btn, atm[mi]); r2[mi] = CKMMA(ktn, atm[mi]); r3[mi] = CKMMA(rtn, btm[mi]); r4[mi] = CKMMA(rtn, ktm[mi]); }
#pragma unroll
        for (int mi = 0; mi < 2; ++mi) { const int mm = 16 * (mtb + mi) + mq;
            f32x4 v = r0[mi];
            v.x = (mm + 0 < nn) ? v.x : 0.f; v.y = (mm + 1 < nn) ? v.y : 0.f; v.z = (mm + 2 < nn) ? v.z : 0.f; v.w = (mm + 3 < nn) ? v.w : 0.f;
            *(LAS v2u*)(CKM(CK_SET0 + 1) + so[mi]) = pack4(v);
            v.x += (mm + 0 == nn) ? 1.f : 0.f; v.y += (mm + 1 == nn) ? 1.f : 0.f; v.z += (mm + 2 == nn) ? 1.f : 0.f; v.w += (mm + 3 == nn) ? 1.f : 0.f;
            *(LAS v2u*)(CKM(CK_SET0 + 2) + so[mi]) = pack4(v);
            v = r1[mi];
            v.x = (nn < mm + 0) ? v.x : 0.f; v.y = (nn < mm + 1) ? v.y : 0.f; v.z = (nn < mm + 2) ? v.z : 0.f; v.w = (nn < mm + 3) ? v.w : 0.f;
            *(LAS v2u*)(CKM(CK_SET0) + so[mi]) = pack4(v);
            v = r2[mi];
            v.x = (nn < mm + 0) ? v.x : 0.f; v.y = (nn < mm + 1) ? v.y : 0.f; v.z = (nn < mm + 2) ? v.z : 0.f; v.w = (nn < mm + 3) ? v.w : 0.f;
            *(LAS v2u*)(CKM(CK_AAK) + so[mi]) = pack4(v);
            v = r3[mi];
            v.x = (mm + 0 <= nn) ? v.x : 0.f; v.y = (mm + 1 <= nn) ? v.y : 0.f; v.z = (mm + 2 <= nn) ? v.z : 0.f; v.w = (mm + 3 <= nn) ? v.w : 0.f;
            *(LAS v2u*)(CKM(CK_ABRT) + so[mi]) = pack4(v);
            v = r4[mi];
            v.x = (mm + 0 <= nn) ? v.x : 0.f; v.y = (mm + 1 <= nn) ? v.y : 0.f; v.z = (mm + 2 <= nn) ? v.z : 0.f; v.w = (mm + 3 <= nn) ? v.w : 0.f;
            *(LAS v2u*)(CKM(CK_AKRT) + so[mi]) = pack4(v); }
    }
    __syncthreads();
#pragma unroll 1
    for (int k = 0; k < 6; ++k) {
        const int sc = (k & 1) ? CK_SET1 : CK_SET0, sn = (k & 1) ? CK_SET0 : CK_SET1;
        bf16x8 bn[2], btn[2], un[2], bm[2][2], btm[2][2]; v2u uold[2];
        CKF(bn, sc, n0); CKF(btn, sc + 1, n0); CKF(un, sn + 2, n0);
#pragma unroll
        for (int mi = 0; mi < 2; ++mi) { CKF(bm[mi], sc, 16 * (mtb + mi)); CKF(btm[mi], sc + 1, 16 * (mtb + mi)); uold[mi] = *(const LAS v2u*)(CKM(sn + 2) + so[mi]); }
        f32x4 r0[2], r1[2], r2[2];
#pragma unroll
        for (int mi = 0; mi < 2; ++mi) { r0[mi] = CKMMA(bn, btm[mi]); r1[mi] = CKMMA(btn, bm[mi]); r2[mi] = CKMMA(un, bm[mi]) + unpack4(uold[mi]); }
#pragma unroll
        for (int mi = 0; mi < 2; ++mi) { const int mm = 16 * (mtb + mi) + mq;
            if (k < 5) { *(LAS v2u*)(CKM(sn) + so[mi]) = pack4(r0[mi]); *(LAS v2u*)(CKM(sn + 1) + so[mi]) = pack4(r1[mi]); }
            if (k > 0) *(LAS v2u*)(CKM(sc + 2) + so[mi]) = pack4(r2[mi]); }
        __syncthreads();
    }
    {
        bf16x8 an[2], gn[2], um[2][2];
        CKF(an, CK_ATT, n0); CKF(gn, CK_AAK, n0);
#pragma unroll
        for (int mi = 0; mi < 2; ++mi) CKF(um[mi], CK_SET1 + 2, 16 * (mtb + mi));
        f32x4 r0[2], r1[2];
#pragma unroll
        for (int mi = 0; mi < 2; ++mi) { r0[mi] = CKMMA(an, um[mi]); r1[mi] = CKMMA(gn, um[mi]); }
#pragma unroll
        for (int mi = 0; mi < 2; ++mi) { const int mm = 16 * (mtb + mi) + mq; *(LAS v2u*)(CKM(CK_AT) + so[mi]) = pack4(r0[mi]); *(LAS v2u*)(CKM(CK_KT) + so[mi]) = pack4(r1[mi]); }
    }
    __syncthreads();
    {
        bf16x8 bhn[2], abn[2], ahm[2][2], gm[2][2]; v2u kh[2], rt[2], ak[2];
        CKF(bhn, CK_BHT, n0); CKF(abn, CK_ABRT, n0);
#pragma unroll
        for (int mi = 0; mi < 2; ++mi) { const int mm = 16 * (mtb + mi) + mq; CKF(ahm[mi], CK_AT, 16 * (mtb + mi)); CKF(gm[mi], CK_KT, 16 * (mtb + mi));
            kh[mi] = *(const LAS v2u*)(CKM(CK_KHT) + so[mi]); rt[mi] = *(const LAS v2u*)(CKM(CK_RT) + so[mi]); ak[mi] = *(const LAS v2u*)(CKM(CK_AKRT) + so[mi]); }
        const float wc = WCs[nn];
        f32x4 r0[2], r1[2], r2[2], r3[2];
#pragma unroll
        for (int mi = 0; mi < 2; ++mi) { r0[mi] = CKMMA(bhn, ahm[mi]); r1[mi] = CKMMA(bhn, gm[mi]) + unpack4(kh[mi]); r2[mi] = CKMMA(abn, ahm[mi]) + unpack4(rt[mi]); r3[mi] = CKMMA(abn, gm[mi]) + unpack4(ak[mi]); }
#pragma unroll
        for (int mi = 0; mi < 2; ++mi) { const int mm = 16 * (mtb + mi) + mq;
            f32x4 v = r0[mi];
            v.x += (mm + 0 == nn) ? wc : 0.f; v.y += (mm + 1 == nn) ? wc : 0.f; v.z += (mm + 2 == nn) ? wc : 0.f; v.w += (mm + 3 == nn) ? wc : 0.f;
            { const int o_ = mm & 15; *(v2u*)(PTg + (((((nn >> 5) * 2 + (mm >> 5)) * 2 + ((mm >> 4) & 1)) * 64 + (nn & 31) + 32 * ((o_ >> 2) & 1)) * 8) + 4 * (o_ >> 3)) = pack4(v); }
            *(LAS v2u*)(CKM(CK_BT) + so[mi]) = pack4(r1[mi]);
            *(v2u*)(YRm + yrt_off(tile, h, (nn >> 4) * 2 + (mm >> 5)) + ((((mm & 31) >> 3) * 16 + (nn & 15)) * 8) + (mm & 7)) = pack4(r2[mi]);
            *(LAS v2u*)(CKM(CK_AAK) + so[mi]) = pack4(r3[mi]); }
    }
    __syncthreads();
    {
        bf16x8 vn_[2], yn[2], em[2][2], vm[2][2];
        CKF(vn_, CK_VT, n0); CKF(yn, CK_AAK, n0);
#pragma unroll
        for (int mi = 0; mi < 2; ++mi) { CKF(em[mi], CK_BT, 16 * (mtb + mi)); CKF(vm[mi], CK_VT, 16 * (mtb + mi)); }
        f32x4 r0[2], r1[2];
#pragma unroll
        for (int mi = 0; mi < 2; ++mi) { r0[mi] = CKMMA(vn_, em[mi]); r1[mi] = CKMMA(yn, vm[mi]); }
#pragma unroll
        for (int mi = 0; mi < 2; ++mi) { const int mm = 16 * (mtb + mi) + mq;
            *(v2u*)(QBg + ((((nn >> 5) * 2 + (mm >> 5)) * 64 + (nn & 31) + 32 * ((mm >> 2) & 1)) * 16) + 4 * ((mm & 31) >> 3)) = pack4(r0[mi]);
            *(v2u*)(YLg + ((((nn >> 4) * 4 + (mm >> 4)) * 64 + ((mm & 15) >> 2) * 16 + (nn & 15)) * 4)) = pack4(r1[mi]); }
    }
#undef CKF
#undef CKMMA
#undef CKM
}

constexpr int YTP = 520;
__device__ __forceinline__ void chunk_out_tile(Frame& F, int tile) {
    const int h = F.wave, lane = F.lane, ci = tile * 8 + h;
    const bf16* YRm = (const bf16*)(F.ws + WS_MIX); const bf16* S0g = (const bf16*)(F.ws + WS_S0) + (size_t)ci * 4096; const bf16* YLg = (const bf16*)(F.ws + WS_YL) + (size_t)ci * 4096;
    LAS bf16* yt = (LAS bf16*)F.lds;
    const int r = lane & 15, kq = lane >> 4;
    bf16x8 yb[4][2], sa[4][2]; v2u yl[4][4];
#pragma unroll
    for (int t = 0; t < 4; ++t) { yb[t][0] = *(const bf16x8*)(YRm + yrt_off(tile, h, t * 2 + 0) + lane * 8); yb[t][1] = *(const bf16x8*)(YRm + yrt_off(tile, h, t * 2 + 1) + lane * 8);
        sa[t][0] = *(const bf16x8*)(S0g + ((t * 2 + 0) * 64 + lane) * 8); sa[t][1] = *(const bf16x8*)(S0g + ((t * 2 + 1) * 64 + lane) * 8);
#pragma unroll
        for (int mt = 0; mt < 4; ++mt) yl[t][mt] = *(const v2u*)(YLg + ((t * 4 + mt) * 64 + lane) * 4); }
#pragma unroll
    for (int nt = 0; nt < 4; ++nt)
#pragma unroll
        for (int mt = 0; mt < 4; ++mt) {
            f32x4 acc = unpack4(yl[nt][mt]);
            acc = __builtin_amdgcn_mfma_f32_16x16x32_bf16(sa[mt][0], yb[nt][0], acc, 0, 0, 0); acc = __builtin_amdgcn_mfma_f32_16x16x32_bf16(sa[mt][1], yb[nt][1], acc, 0, 0, 0);
            *(LAS v2u*)(yt + (16 * nt + r) * YTP + h * 64 + 16 * mt + 4 * kq) = pack4(acc);
        }
}

__device__ __forceinline__ void rwkv_prep(Frame& F, const Args& A, int l, const XDeal xd, unsigned* c1) {
    LAS bf16* act = (LAS bf16*)F.lds;
    const bf16* P = (const bf16*)(F.ws + WS_PROJ);
    const float* mu = (const float*)A.in[5] + l * RW_IN;
    const float* w0 = (const float*)A.in[6] + l * 512; const float* a0 = (const float*)A.in[8] + l * 512;
    const bf16* WuT = (const bf16*)(F.ws + WS_LORA) + (size_t)l * LORA_L; const bf16* AuT = WuT + 512 * 64; const bf16* GuT = AuT + 512 * 64;
    float* RWD = (float*)(F.ws + WS_RWD); bf16* RWA = (bf16*)(F.ws + WS_RWA); bf16* RWG = (bf16*)(F.ws + WS_RWG);
    for (int pp_ = xd.rank; pp_ < xd.U; pp_ += xd.nloc) { const int tile = 4 * xd.rt0 + pp_;
        bf16x8 wu[2][2], au[2][2], gu[2][5];
        int lnl_ = F.lane; asm volatile("" : "+v"(lnl_));
#define LR_LOADW(cp_) do { const int r_ = lnl_ & 15, kq_ = lnl_ >> 4; _Pragma("unroll") for (int c2_ = 0; c2_ < 2; ++c2_) { const int ch0_ = 64 * F.wave + 16 * (2 * (cp_) + c2_); \
            _Pragma("unroll") for (int ks_ = 0; ks_ < 2; ++ks_) { wu[c2_][ks_] = *(const bf16x8*)(WuT + (ch0_ + r_) * 64 + ks_ * 32 + kq_ * 8); au[c2_][ks_] = *(const bf16x8*)(AuT + (ch0_ + r_) * 64 + ks_ * 32 + kq_ * 8); } \
            _Pragma("unroll") for (int ks_ = 0; ks_ < 5; ++ks_) gu[c2_][ks_] = *(const bf16x8*)(GuT + (ch0_ + r_) * 160 + ks_ * 32 + kq_ * 8); } asm volatile("" ::: "memory"); } while (0)
        LR_LOADW(0);
        __syncthreads();
        const bool coh = xd_wait_proj(xd, c1, tile);
#pragma unroll 1
        for (int ib = 0; ib < 3; ++ib) {
            unsigned pc[12], pv_[12];
#pragma unroll
            for (int i = 0; i < 12; ++i) { const int e = F.tid + NTHR * (12 * ib + i), tok = e / 288, c = e % 288, m = tile * 64 + tok, col = RW_WD0 + c;
                pc[i] = P[(size_t)m * NINP + col]; pv_[i] = ((m & (SEQ - 1)) == 0) ? 0u : (coh && tok == 0) ? ld_bf16_dev(P + (size_t)(m - 1) * NINP + col) : (unsigned)P[(size_t)(m - 1) * NINP + col]; }
#pragma unroll
            for (int i = 0; i < 12; ++i) { const int e = F.tid + NTHR * (12 * ib + i), tok = e / 288, c = e % 288, col = RW_WD0 + c;
                const float p = bf2f(pc[i]), pp = bf2f(pv_[i]);
                float s = p + (pp - p) * mu[col];
                if (c < 64) s = tanhf_(s); else if (c >= 128) s = sigmoidf_(s);
                act[tok * ACTP + c] = (bf16)f2bf(s); }
        }
        __syncthreads();
        {
            const int r = F.lane & 15, kq = F.lane >> 4;
#pragma unroll 1
            for (int cp = 0; cp < 2; ++cp) {
                if (cp == 1) LR_LOADW(1);
                const int chl0 = 64 * F.wave + 32 * cp + 4 * kq;
                f32x4 w0v[2], a0v[2];
#pragma unroll
                for (int c2 = 0; c2 < 2; ++c2) { w0v[c2] = *(const f32x4*)(w0 + chl0 + 16 * c2); a0v[c2] = *(const f32x4*)(a0 + chl0 + 16 * c2); }
#pragma unroll 1
                for (int tq = 0; tq < 4; ++tq) { const LAS bf16* ar = act + (16 * tq + r) * ACTP + kq * 8;
                    bf16x8 fa[9];
#pragma unroll
                    for (int k9 = 0; k9 < 9; ++k9) fa[k9] = *(const LAS bf16x8*)(ar + 32 * k9);
                    asm volatile("" ::: "memory");
#pragma unroll
                    for (int c2 = 0; c2 < 2; ++c2) {
                        f32x4 aw = (f32x4){0.f, 0.f, 0.f, 0.f}, aa = aw, ag = aw;
#pragma unroll
                        for (int ks = 0; ks < 2; ++ks) { aw = __builtin_amdgcn_mfma_f32_16x16x32_bf16(wu[c2][ks], fa[ks], aw, 0, 0, 0); aa = __builtin_amdgcn_mfma_f32_16x16x32_bf16(au[c2][ks], fa[2 + ks], aa, 0, 0, 0); }
#pragma unroll
                        for (int ks = 0; ks < 5; ++ks) ag = __builtin_amdgcn_mfma_f32_16x16x32_bf16(gu[c2][ks], fa[4 + ks], ag, 0, 0, 0);
                        const size_t o = (size_t)(tile * 64 + 16 * tq + r) * 512 + chl0 + 16 * c2;
                        f32x4 lw, av;
#pragma unroll
                        for (int jj = 0; jj < 4; ++jj) { lw[jj] = -0.6065306597126334f * sigmoidf_(w0v[c2][jj] + aw[jj]); av[jj] = sigmoidf_(a0v[c2][jj] + aa[jj]); }
                        *(f32x4*)(RWD + o) = lw; *(v2u*)(RWA + o) = pack4(av); *(v2u*)(RWG + o) = pack4(ag); }
                }
            }
        }
        __syncthreads();
        xd_wait(c1 + (32 + (tile >> 3)) * 64, 88u);
        { unsigned qr[8], qk[8], qv[8], qa[8], qp[3]; float qw[8];
          CK_RAWLOAD(0);
#pragma unroll 1
          for (int h = 0; h < 8; ++h) chunk_prep_item(F, A, l, tile, h, coh, qr, qk, qv, qa, qw, qp); }
    }
    __syncthreads();
}

constexpr int ACQP = 200, ACKP = 136, QRP = 100, KVP = 132;
__device__ __forceinline__ void mla_prep(Frame& F, const Args& A, int l, const XDeal xd) {
    LAS bf16* actq = (LAS bf16*)F.lds;
    LAS bf16* actkv = actq + 64 * ACQP;
    LAS float* cs = (LAS float*)(actkv + 64 * ACKP);
    LAS float* sn = cs + 64 * 16;
    LAS float* krr = sn + 64 * 16;
    LAS float* qraw = krr + 64 * 32;
    LAS float* kvraw = qraw + 64 * QRP;
    const bf16* P = (const bf16*)(F.ws + WS_PROJ);
    const int* pos = (const int*)A.in[2];
    const float* qng = (const float*)A.in[16] + l * 192; const float* kvng = (const float*)A.in[18] + l * 128;
    const float* qg = (const float*)A.in[20] + l * 96; const float* kg = (const float*)A.in[21] + l * 96;
    const bf16* WqT = (const bf16*)(F.ws + WS_MLAW) + (size_t)l * MLAW_L; const bf16* WkvT = WqT + 384 * 192;
    bf16* MQ = (bf16*)(F.ws + WS_MQ); bf16* MK = (bf16*)(F.ws + WS_MK); bf16* MV = (bf16*)(F.ws + WS_MV);
    const int tok = F.tid >> 3, s = F.tid & 7;
    for (int pp_ = xd.rank; pp_ < xd.U; pp_ += xd.nloc) { const int tile = 4 * xd.rt0 + pp_;
        const int m0 = tile * 64; const size_t m = (size_t)(m0 + tok);
        __syncthreads();
        {
            const bf16* pr = P + m * NINP;
            float q[24], kv[16]; float sq = 0.f, sk = 0.f;
#pragma unroll
            for (int i = 0; i < 3; ++i) { const v4u w = *(const v4u*)(pr + ML_CQ0 + 24 * s + 8 * i);
                q[8 * i] = bflo(w.x); q[8 * i + 1] = bfhi(w.x); q[8 * i + 2] = bflo(w.y); q[8 * i + 3] = bfhi(w.y); q[8 * i + 4] = bflo(w.z); q[8 * i + 5] = bfhi(w.z); q[8 * i + 6] = bflo(w.w); q[8 * i + 7] = bfhi(w.w); }
#pragma unroll
            for (int i = 0; i < 2; ++i) { const v4u w = *(const v4u*)(pr + ML_CKV0 + 16 * s + 8 * i);
                kv[8 * i] = bflo(w.x); kv[8 * i + 1] = bfhi(w.x); kv[8 * i + 2] = bflo(w.y); kv[8 * i + 3] = bfhi(w.y); kv[8 * i + 4] = bflo(w.z); kv[8 * i + 5] = bfhi(w.z); kv[8 * i + 6] = bflo(w.w); kv[8 * i + 7] = bfhi(w.w); }
#pragma unroll
            for (int i = 0; i < 24; ++i) sq += q[i] * q[i];
#pragma unroll
            for (int i = 0; i < 16; ++i) sk += kv[i] * kv[i];
#pragma unroll
            for (int o = 1; o < 8; o <<= 1) { sq += shx(sq, o); sk += shx(sk, o); }
            const float rq = rsqrtf(sq * (1.0f / 192.0f) + EPS), rk = rsqrtf(sk * (1.0f / 128.0f) + EPS);
#pragma unroll
            for (int i = 0; i < 3; ++i) { v4u w; const int c = 24 * s + 8 * i;
                w.x = pk2(q[8 * i] * rq * qng[c], q[8 * i + 1] * rq * qng[c + 1]); w.y = pk2(q[8 * i + 2] * rq * qng[c + 2], q[8 * i + 3] * rq * qng[c + 3]);
                w.z = pk2(q[8 * i + 4] * rq * qng[c + 4], q[8 * i + 5] * rq * qng[c + 5]); w.w = pk2(q[8 * i + 6] * rq * qng[c + 6], q[8 * i + 7] * rq * qng[c + 7]);
                *(LAS v4u*)(actq + tok * ACQP + c) = w; }
#pragma unroll
            for (int i = 0; i < 2; ++i) { v4u w; const int c = 16 * s + 8 * i;
                w.x = pk2(kv[8 * i] * rk * kvng[c], kv[8 * i + 1] * rk * kvng[c + 1]); w.y = pk2(kv[8 * i + 2] * rk * kvng[c + 2], kv[8 * i + 3] * rk * kvng[c + 3]);
                w.z = pk2(kv[8 * i + 4] * rk * kvng[c + 4], kv[8 * i + 5] * rk * kvng[c + 5]); w.w = pk2(kv[8 * i + 6] * rk * kvng[c + 6], kv[8 * i + 7] * rk * kvng[c + 7]);
                *(LAS v4u*)(actkv + tok * ACKP + c) = w; }
            const v2u kw = *(const v2u*)(pr + ML_KR0 + 4 * s);
            const float kx[4] = {bflo(kw.x), bfhi(kw.x), bflo(kw.y), bfhi(kw.y)};
            const float pf = (float)pos[m];
#pragma unroll
            for (int j = 0; j < 4; ++j) { const int i = (4 * s + j) & 15; const float inv = exp2f(-(float)i * (13.287712379549449f / 16.0f));
                const float ang = pf * inv, c = cosf(ang), sv = sinf(ang);
                const float other = shx(kx[j], 4);
                krr[tok * 32 + 4 * s + j] = (s < 4) ? (kx[j] * c - other * sv) : (kx[j] * c + other * sv);
                if (s < 4) { cs[tok * 16 + i] = c; sn[tok * 16 + i] = sv; } }
        }
        __syncthreads();
        int lnm_ = F.lane; asm volatile("" : "+v"(lnm_));
        const int r = lnm_ & 15, kq = lnm_ >> 4, tq = F.wave & 3, hf = F.wave >> 2;
        bf16x8 wq[3][6], wkv[4][4];
#define ML_LOADW(h_) do { _Pragma("unroll") for (int ct_ = 0; ct_ < 3; ++ct_) _Pragma("unroll") for (int ks_ = 0; ks_ < 6; ++ks_) wq[ct_][ks_] = *(const bf16x8*)(WqT + (size_t)((h_) * 96 + 16 * (3 * hf + ct_) + r) * 192 + ks_ * 32 + kq * 8); asm volatile("" ::: "memory"); } while (0)
#define ML_LOADKV(h_) do { _Pragma("unroll") for (int ct_ = 0; ct_ < 4; ++ct_) _Pragma("unroll") for (int ks_ = 0; ks_ < 4; ++ks_) wkv[ct_][ks_] = *(const bf16x8*)(WkvT + (size_t)((h_) * 128 + 16 * (4 * hf + ct_) + r) * 128 + ks_ * 32 + kq * 8); \
            asm volatile("" ::: "memory"); } while (0)
        ML_LOADW(0);
#pragma unroll 1
        for (int h = 0; h < 4; ++h) {
            {
                const LAS bf16* aq = actq + (16 * tq + r) * ACQP + kq * 8; const LAS bf16* akv = actkv + (16 * tq + r) * ACKP + kq * 8;
                { bf16x8 fa[6];
#pragma unroll
                  for (int ks = 0; ks < 6; ++ks) fa[ks] = *(const LAS bf16x8*)(aq + ks * 32);
#pragma unroll
                  for (int ct = 0; ct < 3; ++ct) { const int d0 = 16 * (3 * hf + ct);
                      f32x4 acc = (f32x4){0.f, 0.f, 0.f, 0.f};
#pragma unroll
                      for (int ks = 0; ks < 6; ++ks) acc = __builtin_amdgcn_mfma_f32_16x16x32_bf16(wq[ct][ks], fa[ks], acc, 0, 0, 0);
                      *(LAS f32x4*)(qraw + (16 * tq + r) * QRP + d0 + 4 * kq) = acc; } }
                ML_LOADKV(h);
                { bf16x8 fk[4];
#pragma unroll
                  for (int ks = 0; ks < 4; ++ks) fk[ks] = *(const LAS bf16x8*)(akv + ks * 32);
#pragma unroll
                  for (int ct = 0; ct < 4; ++ct) { const int e0 = 16 * (4 * hf + ct);
                      f32x4 acc = (f32x4){0.f, 0.f, 0.f, 0.f};
#pragma unroll
                      for (int ks = 0; ks < 4; ++ks) acc = __builtin_amdgcn_mfma_f32_16x16x32_bf16(wkv[ct][ks], fk[ks], acc, 0, 0, 0);
                      *(LAS f32x4*)(kvraw + (16 * tq + r) * KVP + e0 + 4 * kq) = acc; } }
                if (h < 3) ML_LOADW(h + 1);
            }
            __syncthreads();
            {
                float qv[12], kv[12]; float sq = 0.f, sk = 0.f;
#pragma unroll
                for (int dd = 0; dd < 12; ++dd) { const int d = 12 * s + dd;
                    float q = qraw[tok * QRP + d], k;
                    if (d >= 64) { const int rr = d - 64, i = rr & 15; const float c = cs[tok * 16 + i], sv = sn[tok * 16 + i];
                        q = (rr < 16) ? (q * c - qraw[tok * QRP + d + 16] * sv) : (q * c + qraw[tok * QRP + d - 16] * sv);
                        k = krr[tok * 32 + rr];
                    } else k = kvraw[tok * KVP + d];
                    qv[dd] = q; kv[dd] = k; sq += q * q; sk += k * k; }
#pragma unroll
                for (int o = 1; o < 8; o <<= 1) { sq += shx(sq, o); sk += shx(sk, o); }
                const float rq = rsqrtf(sq * (1.0f / 96.0f) + EPS) * 0.14724445052402816f, rk = rsqrtf(sk * (1.0f / 96.0f) + EPS);
#pragma unroll
                for (int g = 0; g < 3; ++g) { const int d = 12 * s + 4 * g; v2u wq, wk;
                    wq.x = pk2(qv[4 * g] * rq * qg[d], qv[4 * g + 1] * rq * qg[d + 1]); wq.y = pk2(qv[4 * g + 2] * rq * qg[d + 2], qv[4 * g + 3] * rq * qg[d + 3]);
                    wk.x = pk2(kv[4 * g] * rk * kg[d], kv[4 * g + 1] * rk * kg[d + 1]); wk.y = pk2(kv[4 * g + 2] * rk * kg[d + 2], kv[4 * g + 3] * rk * kg[d + 3]);
                    *(v2u*)(MQ + m * 384 + h * 96 + d) = wq; *(v2u*)(MK + m * 384 + h * 96 + d) = wk; }
                { const int dv = F.tid >> 3, t8 = 8 * (F.tid & 7); v4u w;
                  w.x = pk2(kvraw[(t8 + 0) * KVP + 64 + dv], kvraw[(t8 + 1) * KVP + 64 + dv]); w.y = pk2(kvraw[(t8 + 2) * KVP + 64 + dv], kvraw[(t8 + 3) * KVP + 64 + dv]);
                  w.z = pk2(kvraw[(t8 + 4) * KVP + 64 + dv], kvraw[(t8 + 5) * KVP + 64 + dv]); w.w = pk2(kvraw[(t8 + 6) * KVP + 64 + dv], kvraw[(t8 + 7) * KVP + 64 + dv]);
                  bf16* vrow = MV + ((size_t)(((m0 >> 13) * 4 + h) * 64 + dv) << 13) + (m0 & (SEQ - 1)) + (t8 & ~15);
                  *(v2u*)(vrow + ((t8 & 8) ? 4 : 0)) = (v2u){w.x, w.y}; *(v2u*)(vrow + ((t8 & 8) ? 12 : 8)) = (v2u){w.z, w.w}; }
            }
            __syncthreads();
        }
    }
    __syncthreads();
#undef ML_LOADW
#undef ML_LOADKV
}

constexpr int GVP = 144, GUP = 72;
__device__ __forceinline__ void gmlp_stage(Frame& F, const Args& A, int l, const XDeal xd) {
    LAS bf16* vnT = (LAS bf16*)F.lds;
    LAS bf16* ug = vnT + 64 * GVP;
    const bf16* P = (const bf16*)(F.ws + WS_PROJ); bf16* MIXp = (bf16*)(F.ws + WS_MIX);
    const float* vg = (const float*)A.in[22] + l * 256; const float* gb = (const float*)A.in[24] + l * 4 * 128;
    const int t = F.tid >> 2, dq = F.tid & 3;
    v4u v0, v1, u0, u1;
#define GM_RAWLOAD(item_) do { const int g_ = (item_) & 3; const size_t m_ = (size_t)((item_) >> 2) * 128 + t; \
        v0 = *(const v4u*)(P + m_ * NINP + GM_V0 + g_ * 64 + 16 * dq); v1 = *(const v4u*)(P + m_ * NINP + GM_V0 + g_ * 64 + 16 * dq + 8); \
        u0 = *(const v4u*)(P + m_ * NINP + GM_U0 + g_ * 64 + 16 * dq); u1 = *(const v4u*)(P + m_ * NINP + GM_U0 + g_ * 64 + 16 * dq + 8); } while (0)
    const int nit = 2 * ((xd.U - xd.rank + xd.nloc - 1) / xd.nloc);
#define GM_ITEM(k_) (8 * xd.rt0 + 2 * (xd.rank + ((k_) >> 1) * xd.nloc) + ((k_) & 1))
    if (nit > 0) GM_RAWLOAD(GM_ITEM(0));
    for (int k = 0; k < nit; ++k) { const int item = GM_ITEM(k);
        const int g = item & 3, ch = item >> 2;
        const bf16* WS = (const bf16*)(F.ws + WS_GWS) + (size_t)(l * 4 + g) * 16384;
        bf16x8 lf[4];
#pragma unroll
        for (int ks = 0; ks < 4; ++ks) lf[ks] = *(const bf16x8*)(WS + (16 * F.wave + (F.lane & 15)) * 128 + ks * 32 + (F.lane >> 4) * 8);
        const float bias = gb[g * 128 + 16 * F.wave + (F.lane & 15)];
        __syncthreads();
        {
            float z[16], uu[16]; float ss = 0.f;
            const unsigned vw[8] = {v0.x, v0.y, v0.z, v0.w, v1.x, v1.y, v1.z, v1.w}, uw[8] = {u0.x, u0.y, u0.z, u0.w, u1.x, u1.y, u1.z, u1.w};
#pragma unroll
            for (int i = 0; i < 8; ++i) { z[2 * i] = gelu_tanh(bflo(vw[i])); z[2 * i + 1] = gelu_tanh(bfhi(vw[i])); uu[2 * i] = gelu_tanh(bflo(uw[i])); uu[2 * i + 1] = gelu_tanh(bfhi(uw[i])); ss += z[2 * i] * z[2 * i] + z[2 * i + 1] * z[2 * i + 1]; }
            if (k + 1 < nit) GM_RAWLOAD(GM_ITEM(k + 1));
            ss += shx(ss, 1); ss += shx(ss, 2);
            const float rstd = rsqrtf(ss * (1.0f / 64.0f) + EPS);
#pragma unroll
            for (int i = 0; i < 16; ++i) vnT[(16 * dq + i) * GVP + t] = (bf16)f2bf(z[i] * rstd * vg[g * 64 + 16 * dq + i]);
            v4u w0, w1; w0.x = pk2(uu[0], uu[1]); w0.y = pk2(uu[2], uu[3]); w0.z = pk2(uu[4], uu[5]); w0.w = pk2(uu[6], uu[7]); w1.x = pk2(uu[8], uu[9]); w1.y = pk2(uu[10], uu[11]); w1.z = pk2(uu[12], uu[13]); w1.w = pk2(uu[14], uu[15]);
            *(LAS v4u*)(ug + t * GUP + 16 * dq) = w0; *(LAS v4u*)(ug + t * GUP + 16 * dq + 8) = w1;
        }
        __syncthreads();
        {
            const int r = F.lane & 15, kq = F.lane >> 4, tt = F.wave;
            const int nks = (16 * tt + 15) / 32 + 1;
            f32x4 acc[4];
#pragma unroll
            for (int dt = 0; dt < 4; ++dt) acc[dt] = (f32x4){0.f, 0.f, 0.f, 0.f};
#pragma unroll
            for (int ks = 0; ks < 4; ++ks) if (ks < nks) {
#pragma unroll
                for (int dt = 0; dt < 4; ++dt) acc[dt] = __builtin_amdgcn_mfma_f32_16x16x32_bf16(*(const LAS bf16x8*)(vnT + (16 * dt + r) * GVP + ks * 32 + kq * 8), lf[ks], acc[dt], 0, 0, 0); }
            const int tl = 16 * tt + r;
#pragma unroll
            for (int dt = 0; dt < 4; ++dt) { const f32x4 uv = unpack4(*(const LAS v2u*)(ug + tl * GUP + 16 * dt + 4 * kq));
                *(v2u*)(MIXp + ((size_t)ch * 128 + tl) * 1024 + MIX_GM0 + g * 64 + 16 * dt + 4 * kq) = pack4(uv * (acc[dt] + bias)); }
        }
    }
#undef GM_RAWLOAD
#undef GM_ITEM
    __syncthreads();
}

typedef float f32x16 __attribute__((ext_vector_type(16)));
struct ScanOps { v4u pt[2][2][2]; v4u qb[2][2]; };
__device__ __forceinline__ void scan_load(ScanOps& o, const GAS bf16* PTc, const GAS bf16* QBc, int lane, int vh) {
#pragma unroll
    for (int kb2 = 0; kb2 < 2; ++kb2) {
#pragma unroll
        for (int kb1 = 0; kb1 < 2; ++kb1)
#pragma unroll
            for (int s = 0; s < 2; ++s) o.pt[kb2][kb1][s] = *(const GAS v4u*)(PTc + ((((kb2 * 2 + kb1) * 2 + s) * 64 + lane) * 8));
        const GAS bf16* q = QBc + (((vh * 2 + kb2) * 64 + lane) * 16);
        o.qb[kb2][0] = *(const GAS v4u*)q; o.qb[kb2][1] = *(const GAS v4u*)(q + 8); }
}
__device__ __forceinline__ void scan_step(f32x16 (&acc)[2], const ScanOps& cur, ScanOps& nxt, bool more, const GAS bf16* PTn, const GAS bf16* QBn, GAS bf16* S0c, int lane, int vh) {
    const int hh = lane >> 5, vv = 32 * vh + (lane & 31);
    bf16x8 bfr[2][2];
#pragma unroll
    for (int kb = 0; kb < 2; ++kb) {
#pragma unroll
        for (int g = 0; g < 4; ++g) { v2u w; w.x = pk2(acc[kb][4 * g], acc[kb][4 * g + 1]); w.y = pk2(acc[kb][4 * g + 2], acc[kb][4 * g + 3]);
            *(GAS v2u*)(S0c + ((((vv >> 4) * 2 + kb) * 64 + g * 16 + (vv & 15)) * 8) + 4 * hh) = w;
            const int s = g >> 1, o = (g & 1) * 4;
            bfr[kb][s][o] = (short)(w.x & 0xffffu); bfr[kb][s][o + 1] = (short)(w.x >> 16); bfr[kb][s][o + 2] = (short)(w.y & 0xffffu); bfr[kb][s][o + 3] = (short)(w.y >> 16); } }
    if (more) scan_load(nxt, PTn, QBn, lane, vh);
#pragma unroll
    for (int kb2 = 0; kb2 < 2; ++kb2) {
        f32x16 nacc;
        { const v4u q0 = cur.qb[kb2][0], q1 = cur.qb[kb2][1];
          nacc[0] = bflo(q0.x); nacc[1] = bfhi(q0.x); nacc[2] = bflo(q0.y); nacc[3] = bfhi(q0.y); nacc[4] = bflo(q0.z); nacc[5] = bfhi(q0.z); nacc[6] = bflo(q0.w); nacc[7] = bfhi(q0.w);
          nacc[8] = bflo(q1.x); nacc[9] = bfhi(q1.x); nacc[10] = bflo(q1.y); nacc[11] = bfhi(q1.y); nacc[12] = bflo(q1.z); nacc[13] = bfhi(q1.z); nacc[14] = bflo(q1.w); nacc[15] = bfhi(q1.w); }
#pragma unroll
        for (int kb1 = 0; kb1 < 2; ++kb1)
#pragma unroll
            for (int s = 0; s < 2; ++s) { const bf16x8 a = __builtin_bit_cast(bf16x8, cur.pt[kb2][kb1][s]);
                nacc = __builtin_amdgcn_mfma_f32_32x32x16_bf16(a, bfr[kb1][s], nacc, 0, 0, 0); }
        acc[kb2] = nacc;
    }
}
__device__ __forceinline__ void rwkv_state_scan(Frame& F) {
    if (F.bid >= 16 || F.wave >= 2) return;
    const int gw = F.bid * 2 + F.wave, bh = gw >> 1, vh = gw & 1, b = bh >> 3, h = bh & 7;
    const int lane = F.lane;
    const GAS bf16* PTb = (const GAS bf16*)(F.ws + WS_PT) + (size_t)((b * 128) * 8 + h) * 4096; const GAS bf16* QBb = (const GAS bf16*)(F.ws + WS_QB) + (size_t)((b * 128) * 8 + h) * 4096;
    GAS bf16* S0b = (GAS bf16*)(F.ws + WS_S0) + (size_t)((b * 128) * 8 + h) * 4096;
    f32x16 acc[2];
#pragma unroll
    for (int kb = 0; kb < 2; ++kb)
#pragma unroll
        for (int i = 0; i < 16; ++i) acc[kb][i] = 0.f;
    ScanOps o0, o1;
    scan_load(o0, PTb, QBb, lane, vh);
    constexpr size_t CS = 8 * 4096;
#pragma unroll 1
    for (int c = 0; c < 128; c += 2) {
        scan_step(acc, o0, o1, true, PTb + (size_t)(c + 1) * CS, QBb + (size_t)(c + 1) * CS, S0b + (size_t)c * CS, lane, vh);
        scan_step(acc, o1, o0, c + 2 < 128, PTb + (size_t)(c + 2) * CS, QBb + (size_t)(c + 2) * CS, S0b + (size_t)(c + 1) * CS, lane, vh);
    }
}

constexpr int AKP = 104, AVP = 72;
constexpr int ABUF = 64 * AKP * 2 + 64 * AVP * 2;
__device__ __forceinline__ void attn_tile(const LAS bf16* Kb, const bf16x8 (&qf)[6], f32x16 (&o)[2], float& lrun, int key0, int qmin, int qpos, int ql, int hh) {
    const LAS bf16* Vb = Kb + 64 * AKP;
    if (key0 > qmin + 31) return;
    f32x16 st[2];
    {
        bf16x8 kf[2][6];
#pragma unroll
        for (int sub = 0; sub < 2; ++sub)
#pragma unroll
            for (int s = 0; s < 6; ++s) kf[sub][s] = *(const LAS bf16x8*)(Kb + (32 * sub + ql) * AKP + 16 * s + 8 * hh);
        asm volatile("" ::: "memory");
#pragma unroll
        for (int sub = 0; sub < 2; ++sub) {
#pragma unroll
            for (int i = 0; i < 16; ++i) st[sub][i] = 0.f;
#pragma unroll
            for (int s = 0; s < 6; ++s) st[sub] = __builtin_amdgcn_mfma_f32_32x32x16_bf16(kf[sub][s], qf[s], st[sub], 0, 0, 0);
        }
    }
    bf16x8 vf[2][2][2];
#pragma unroll
    for (int mt = 0; mt < 2; ++mt)
#pragma unroll
        for (int sub = 0; sub < 2; ++sub)
#pragma unroll
            for (int s2 = 0; s2 < 2; ++s2) vf[mt][sub][s2] = *(const LAS bf16x8*)(Vb + (32 * mt + ql) * AVP + 32 * sub + 16 * s2 + 8 * hh);
    asm volatile("" ::: "memory");
    if (key0 + 63 > qmin) {
#pragma unroll
        for (int sub = 0; sub < 2; ++sub)
#pragma unroll
            for (int i = 0; i < 16; ++i) { const int key = key0 + 32 * sub + (i & 3) + 8 * (i >> 2) + 4 * hh; st[sub][i] = (key > qpos) ? -1.0e30f : st[sub][i]; }
    }
    float ps = 0.f;
#pragma unroll
    for (int sub = 0; sub < 2; ++sub)
#pragma unroll
        for (int i = 0; i < 16; ++i) { const float p = __builtin_amdgcn_exp2f(st[sub][i]); st[sub][i] = p; ps += p; }
    lrun += ps;
    bf16x8 pf[2][2];
#pragma unroll
    for (int sub = 0; sub < 2; ++sub)
#pragma unroll
        for (int s2 = 0; s2 < 2; ++s2) { v4u pw; pw.x = pk2(st[sub][8 * s2], st[sub][8 * s2 + 1]); pw.y = pk2(st[sub][8 * s2 + 2], st[sub][8 * s2 + 3]); pw.z = pk2(st[sub][8 * s2 + 4], st[sub][8 * s2 + 5]); pw.w = pk2(st[sub][8 * s2 + 6], st[sub][8 * s2 + 7]);
            pf[sub][s2] = __builtin_bit_cast(bf16x8, pw); }
#pragma unroll
    for (int mt = 0; mt < 2; ++mt)
#pragma unroll
        for (int sub = 0; sub < 2; ++sub)
#pragma unroll
            for (int s2 = 0; s2 < 2; ++s2)
                o[mt] = __builtin_amdgcn_mfma_f32_32x32x16_bf16(vf[mt][sub][s2], pf[sub][s2], o[mt], 0, 0, 0);
}
struct AttnStage { v4u k0, k1, k2, v, w; };
constexpr int ATT_PER_BH = 2112, ATT_TOTAL = 8 * ATT_PER_BH, ATT_LS = 8, ATT_LN = 72, ATT_NS = 16;
constexpr size_t WS_PART = WS_RWD;
constexpr int PART_SZ = 256 * 64 * 2 + 256 * 8;
static_assert((size_t)512 * PART_SZ <= (size_t)32 * MiB, "partials fit the dead decay buffer");
__device__ __forceinline__ int att_vb(int c) { return ((c & 7) << 5) | (c >> 3); }
__device__ __forceinline__ int att_cut(int j) {
    constexpr int C[33] = {0, 12, 28, 92, 160, 228, 300, 368, 440, 512, 584, 656, 728, 800, 872, 944, 1016, 1088, 1160, 1232, 1304, 1376, 1448, 1520, 1592, 1664, 1736, 1808, 1880, 1952, 2024, 2096, 2112};
    int v = 0;
#pragma unroll
    for (int i = 1; i < 33; ++i) v = (j >= i) ? C[i] : v;
    return v;
}
__device__ __forceinline__ int att_start(int vb) { return (vb >> 5) * ATT_PER_BH + att_cut(vb & 31); }
__device__ __forceinline__ int att_blockof(int g) { const int x = g / ATT_PER_BH, loc = g % ATT_PER_BH; int j = 0;
#pragma unroll
    for (int i = 1; i < 32; ++i) j += (loc >= att_cut(i)) ? 1 : 0;
    return x * 32 + j; }
__device__ __forceinline__ void attn_piece(Frame& F, int b, int h, int qb, int kt0, int kt1, unsigned char* part) {
    const bf16* MQ = (const bf16*)(F.ws + WS_MQ); const bf16* MK = (const bf16*)(F.ws + WS_MK); const bf16* MVT = (const bf16*)(F.ws + WS_MV);
    bf16* MIXp = (bf16*)(F.ws + WS_MIX);
    const int lane = F.lane, w = F.wave, hh = lane >> 5, ql = lane & 31;
    const int qmin = qb * 256 + 32 * w, qpos = qmin + ql;
    const size_t m = (size_t)b * SEQ + qpos;
    bf16x8 qf[6];
#pragma unroll
    for (int s = 0; s < 6; ++s) qf[s] = *(const bf16x8*)(MQ + m * 384 + h * 96 + 16 * s + 8 * hh);
    f32x16 o[2];
#pragma unroll
    for (int i = 0; i < 16; ++i) { o[0][i] = 0.f; o[1][i] = 0.f; }
    float lrun = 0.f;
    const int c0_ = F.tid, c1_ = F.tid + 512, c2_ = F.tid + 1024;
    const int kr0 = c0_ / 12, kc0 = c0_ % 12, kr1 = c1_ / 12, kc1 = c1_ % 12, kr2 = c2_ / 12, kc2 = c2_ % 12, vr = F.tid >> 3, vc = F.tid & 7;
    const int ko0 = ((kr0 >> 6) * (ABUF / 2)) + (kr0 & 63) * AKP + 8 * kc0, ko1 = ((kr1 >> 6) * (ABUF / 2)) + (kr1 & 63) * AKP + 8 * kc1, ko2 = ((kr2 >> 6) * (ABUF / 2)) + (kr2 & 63) * AKP + 8 * kc2;
    const bf16* kg = MK + (size_t)b * SEQ * 384 + h * 96; const bf16* vg = MVT + ((size_t)((b * 4 + h) * 64 + vr) << 13) + 8 * vc;
#define ATT_LOAD(R, kt_) do { const size_t ko_ = (size_t)(kt_) * 64; R.k0 = *(const v4u*)(kg + (ko_ + kr0) * 384 + 8 * kc0); R.k1 = *(const v4u*)(kg + (ko_ + kr1) * 384 + 8 * kc1); R.k2 = *(const v4u*)(kg + (ko_ + kr2) * 384 + 8 * kc2); \
        R.v = *(const v4u*)(vg + ko_); R.w = *(const v4u*)(vg + ko_ + 64); } while (0)
#define ATT_WRITE(R, slot_) do { LAS bf16* B_ = (LAS bf16*)(F.lds + (slot_) * 2 * ABUF); *(LAS v4u*)(B_ + ko0) = R.k0; *(LAS v4u*)(B_ + ko1) = R.k1; *(LAS v4u*)(B_ + ko2) = R.k2; \
        *(LAS v4u*)(B_ + 64 * AKP + vr * AVP + 8 * vc) = R.v; *(LAS v4u*)(B_ + ABUF / 2 + 64 * AKP + vr * AVP + 8 * vc) = R.w; } while (0)
    AttnStage RA, RB;
    __syncthreads();
    ATT_LOAD(RA, kt0); ATT_LOAD(RB, kt0 + 2);
    ATT_WRITE(RA, 0);
    __syncthreads();
#pragma unroll 1
    for (int kt = kt0; kt < kt1; kt += 4) {
        if (kt + 4 < kt1) ATT_LOAD(RA, kt + 4);
        attn_tile((const LAS bf16*)F.lds, qf, o, lrun, kt * 64, qmin, qpos, ql, hh);
        ATT_WRITE(RB, 1);
        attn_tile((const LAS bf16*)(F.lds + ABUF), qf, o, lrun, (kt + 1) * 64, qmin, qpos, ql, hh);
        __syncthreads();
        if (kt + 6 < kt1) ATT_LOAD(RB, kt + 6);
        attn_tile((const LAS bf16*)(F.lds + 2 * ABUF), qf, o, lrun, (kt + 2) * 64, qmin, qpos, ql, hh);
        if (kt + 4 < kt1) ATT_WRITE(RA, 0);
        attn_tile((const LAS bf16*)(F.lds + 3 * ABUF), qf, o, lrun, (kt + 3) * 64, qmin, qpos, ql, hh);
        __syncthreads();
    }
#undef ATT_LOAD
#undef ATT_WRITE
    const float lt = lrun + shx(lrun, 32);
    if (part == nullptr) { const float il = 1.0f / lt;
#pragma unroll
        for (int mt = 0; mt < 2; ++mt)
#pragma unroll
            for (int g = 0; g < 4; ++g) { v2u wv; wv.x = pk2(o[mt][4 * g] * il, o[mt][4 * g + 1] * il); wv.y = pk2(o[mt][4 * g + 2] * il, o[mt][4 * g + 3] * il);
                *(v2u*)(MIXp + m * 1024 + MIX_MLA0 + h * 64 + 32 * mt + 8 * g + 4 * hh) = wv; }
    } else { bf16* po = (bf16*)part; float* pml = (float*)(part + 256 * 64 * 2); const int row = 32 * w + ql;
#pragma unroll
        for (int mt = 0; mt < 2; ++mt)
#pragma unroll
            for (int g = 0; g < 4; ++g) { v2u wv; wv.x = pk2(o[mt][4 * g], o[mt][4 * g + 1]); wv.y = pk2(o[mt][4 * g + 2], o[mt][4 * g + 3]);
                *(v2u*)(po + row * 64 + 32 * mt + 8 * g + 4 * hh) = wv; }
        if (hh == 0) { pml[2 * row] = 0.f; pml[2 * row + 1] = lt; }
    }
}
__device__ __forceinline__ void attn_mfma(Frame& F) {
    const int vb = att_vb(F.bid); int g = att_start(vb); const int gend = att_start(vb + 1); int k = 0;
    while (g < gend) {
        const int bh = g / ATT_PER_BH, r = g % ATT_PER_BH;
        int x = 0; while (2 * (x + 1) * (x + 2) <= r) ++x;
        const int kt0 = r - 2 * x * (x + 1), n = 4 * (x + 1);
        const int kt1 = (kt0 + (gend - g) < n) ? kt0 + (gend - g) : n;
        const bool whole = (kt0 == 0 && kt1 == n);
        attn_piece(F, bh >> 2, bh & 3, x, kt0, kt1, whole ? nullptr : (unsigned char*)(F.ws + WS_PART) + (size_t)(vb * 2 + (k == 0 ? 0 : 1)) * PART_SZ);
        g += kt1 - kt0; ++k;
    }
    __syncthreads();
}
__device__ __forceinline__ void attn_merge(Frame& F, const XDeal xd) {
    bf16* MIXp = (bf16*)(F.ws + WS_MIX);
    for (int pp = xd.rank; pp < xd.U; pp += xd.nloc) { const int R_ = xd.rt0 + (pp >> 2);
        const int bh = (R_ >> 5) * 4 + (pp & 3), x = R_ & 31, a = bh * ATT_PER_BH + 2 * x * (x + 1), bnd = a + 4 * (x + 1);
        const int c0 = att_blockof(a), c1 = att_blockof(bnd - 1);
        if (c0 == c1 && att_start(c0) <= a && bnd <= att_start(c0 + 1)) continue;
        const int row = F.tid >> 1, hf = F.tid & 1;
        float acc[32]; float lsum = 0.f;
#pragma unroll
        for (int i = 0; i < 32; ++i) acc[i] = 0.f;
        for (int c = c0; c <= c1; ++c) { const int slot = c * 2 + ((att_start(c) >= a) ? 0 : 1);
            const unsigned char* pp = (const unsigned char*)(F.ws + WS_PART) + (size_t)slot * PART_SZ; const float* pml = (const float*)(pp + 256 * 64 * 2);
            const float sc = 1.0f; lsum += pml[2 * row + 1];
            const bf16* po = (const bf16*)pp + row * 64 + 32 * hf;
#pragma unroll
            for (int q = 0; q < 4; ++q) { const v4u wv = *(const v4u*)(po + 8 * q);
                acc[8 * q] += bflo(wv.x) * sc; acc[8 * q + 1] += bfhi(wv.x) * sc; acc[8 * q + 2] += bflo(wv.y) * sc; acc[8 * q + 3] += bfhi(wv.y) * sc;
                acc[8 * q + 4] += bflo(wv.z) * sc; acc[8 * q + 5] += bfhi(wv.z) * sc; acc[8 * q + 6] += bflo(wv.w) * sc; acc[8 * q + 7] += bfhi(wv.w) * sc; } }
        const float il = 1.0f / lsum;
        const size_t m = (size_t)(bh >> 2) * SEQ + x * 256 + row;
#pragma unroll
        for (int q = 0; q < 4; ++q) { v4u wv; wv.x = pk2(acc[8 * q] * il, acc[8 * q + 1] * il); wv.y = pk2(acc[8 * q + 2] * il, acc[8 * q + 3] * il); wv.z = pk2(acc[8 * q + 4] * il, acc[8 * q + 5] * il); wv.w = pk2(acc[8 * q + 6] * il, acc[8 * q + 7] * il);
            *(v4u*)(MIXp + m * 1024 + MIX_MLA0 + (bh & 3) * 64 + 32 * hf + 8 * q) = wv; }
    }
}

__device__ __forceinline__ void rwkv_out(Frame& F, const Args& A, int l, const XDeal xd, unsigned* cd) {
    const bf16* P = (const bf16*)(F.ws + WS_PROJ); bf16* MIX = (bf16*)(F.ws + WS_MIX);
    const bf16* RWA = (const bf16*)(F.ws + WS_RWA); const bf16* RWG = (const bf16*)(F.ws + WS_RWG);
    const float* mu = (const float*)A.in[5] + l * RW_IN;
    const int c0 = F.lane * 8;
    const float* ka = (const float*)A.in[12] + l * 512 + c0; const float* rk = (const float*)A.in[13] + l * 512 + c0;
    const float* lg = (const float*)A.in[14] + l * 512 + c0; const float* lb = (const float*)A.in[15] + l * 512 + c0;
    for (int pp = xd.rank; pp < xd.U; pp += xd.nloc) { const int tile = 4 * xd.rt0 + pp;
      __syncthreads();
      chunk_out_tile(F, tile);
      __syncthreads();
      for (int ti = 0; ti < 8; ++ti) { const int m = tile * 64 + F.wave * 8 + ti;
        const bool first = (m & (SEQ - 1)) == 0;
        float y[8], r[8], k[8], v[8], a[8], g[8];
        const v4u yy = *(const LAS v4u*)((const LAS bf16*)F.lds + (F.wave * 8 + ti) * YTP + c0), aa = *(const v4u*)(RWA + (size_t)m * 512 + c0), gg = *(const v4u*)(RWG + (size_t)m * 512 + c0);
        const unsigned yw[4] = {yy.x, yy.y, yy.z, yy.w}, aw[4] = {aa.x, aa.y, aa.z, aa.w}, gw4[4] = {gg.x, gg.y, gg.z, gg.w};
#pragma unroll
        for (int i = 0; i < 4; ++i) { y[2 * i] = bflo(yw[i]); y[2 * i + 1] = bfhi(yw[i]); a[2 * i] = bflo(aw[i]); a[2 * i + 1] = bfhi(aw[i]); g[2 * i] = bflo(gw4[i]); g[2 * i + 1] = bfhi(gw4[i]); }
#pragma unroll
        for (int s = 0; s < 3; ++s) { const int col = (s == 0 ? RW_R0 : s == 1 ? RW_K0 : RW_V0) + c0;
            const v4u c4 = *(const v4u*)(P + (size_t)m * NINP + col); v4u p4 = (v4u){0u, 0u, 0u, 0u}; if (!first) p4 = *(const v4u*)(P + (size_t)(m - 1) * NINP + col);
            const unsigned cw[4] = {c4.x, c4.y, c4.z, c4.w}, pw[4] = {p4.x, p4.y, p4.z, p4.w};
#pragma unroll
            for (int i = 0; i < 8; ++i) { const float cv = (i & 1) ? bfhi(cw[i >> 1]) : bflo(cw[i >> 1]), pvv = (i & 1) ? bfhi(pw[i >> 1]) : bflo(pw[i >> 1]);
                const float sv = cv + (pvv - cv) * mu[col + i]; if (s == 0) r[i] = sv; else if (s == 1) k[i] = sv; else v[i] = sv; } }
        float sm = 0.f, bon = 0.f;
#pragma unroll
        for (int i = 0; i < 8; ++i) { sm += y[i]; const float k2 = k[i] * (1.0f + (a[i] - 1.0f) * ka[i]); bon += r[i] * k2 * rk[i]; }
#pragma unroll
        for (int o = 1; o < 8; o <<= 1) { sm += shx(sm, o); bon += shx(bon, o); }
        const float mean = sm * (1.0f / 64.0f); float vr = 0.f;
#pragma unroll
        for (int i = 0; i < 8; ++i) { const float d = y[i] - mean; vr += d * d; }
#pragma unroll
        for (int o = 1; o < 8; o <<= 1) vr += shx(vr, o);
        const float rstd = rsqrtf(vr * (1.0f / 64.0f) + GN_EPS);
        float ov[8];
#pragma unroll
        for (int i = 0; i < 8; ++i) ov[i] = ((y[i] - mean) * rstd * lg[i] + lb[i] + bon * v[i]) * g[i];
        v4u o4; o4.x = pk2(ov[0], ov[1]); o4.y = pk2(ov[2], ov[3]); o4.z = pk2(ov[4], ov[5]); o4.w = pk2(ov[6], ov[7]);
        *(v4u*)(MIX + (size_t)m * 1024 + c0) = o4;
      }
      xd_signal(cd + (tile >> 2) * 64);
    }
}

constexpr size_t WS_MKF = WS_MN, WS_MVF = WS_MN + 256 * 1024;
__device__ __forceinline__ void memkv_arrange(Frame& F, const Args& A) {
    if (F.bid < 16 || F.bid >= 24) return;
    const int bh = F.bid - 16, b = bh >> 2, h = bh & 3;
    const float* MKV = (const float*)(F.ws + WS_MKV); const float* kg = (const float*)A.in[28];
    bf16* KF = (bf16*)(F.ws + WS_MKF) + (size_t)bh * 16384; bf16* VF = (bf16*)(F.ws + WS_MVF) + (size_t)bh * 16384;
    { const int key = F.tid >> 1, hf = F.tid & 1;
      const float* kp = MKV + (size_t)(b * 256 + key) * 512 + h * 64 + 32 * hf;
      float kv[32]; float ss = 0.f;
#pragma unroll
      for (int i = 0; i < 8; ++i) { const f32x4 x = *(const f32x4*)(kp + 4 * i); kv[4 * i] = x.x; kv[4 * i + 1] = x.y; kv[4 * i + 2] = x.z; kv[4 * i + 3] = x.w; ss += (x.x * x.x + x.y * x.y) + (x.z * x.z + x.w * x.w); }
      ss += shx(ss, 1);
      const float rstd = rsqrtf(ss * (1.0f / 64.0f) + EPS);
      const int kt = key >> 6, sub = (key >> 5) & 1, ql = key & 31;
#pragma unroll
      for (int i = 0; i < 4; ++i) { const int d0 = 32 * hf + 8 * i, sI = d0 >> 4, hh = (d0 >> 3) & 1; v4u w;
          w.x = pk2(kv[8 * i] * rstd * kg[d0], kv[8 * i + 1] * rstd * kg[d0 + 1]); w.y = pk2(kv[8 * i + 2] * rstd * kg[d0 + 2], kv[8 * i + 3] * rstd * kg[d0 + 3]);
          w.z = pk2(kv[8 * i + 4] * rstd * kg[d0 + 4], kv[8 * i + 5] * rstd * kg[d0 + 5]); w.w = pk2(kv[8 * i + 6] * rstd * kg[d0 + 6], kv[8 * i + 7] * rstd * kg[d0 + 7]);
          *(v4u*)(KF + ((((kt * 2 + sub) * 4 + sI) * 64 + ql + 32 * hh) * 8)) = w; } }
    { const int dv = F.tid & 63, grp = F.tid >> 6, kt = grp >> 1, sub = grp & 1, mt = dv >> 5, ql = dv & 31;
      const float* vp = MKV + (size_t)(b * 256 + 64 * kt + 32 * sub) * 512 + 256 + h * 64 + dv;
#pragma unroll
      for (int s2 = 0; s2 < 2; ++s2)
#pragma unroll
          for (int hh = 0; hh < 2; ++hh) { float v[8];
#pragma unroll
              for (int j = 0; j < 8; ++j) v[j] = vp[(size_t)(16 * s2 + 8 * (j >> 2) + 4 * hh + (j & 3)) * 512];
              v4u w; w.x = pk2(v[0], v[1]); w.y = pk2(v[2], v[3]); w.z = pk2(v[4], v[5]); w.w = pk2(v[6], v[7]);
              *(v4u*)(VF + (((((kt * 2 + mt) * 2 + sub) * 2 + s2) * 64 + ql + 32 * hh) * 8)) = w; } }
}

constexpr int MAP = 1040, MQP = 264;
__device__ __forceinline__ void mem_q_attn(Frame& F, const Args& A, int l, const XDeal xd, unsigned* cw, unsigned* cd) {
    LAS bf16* xa = (LAS bf16*)F.lds;
    LAS bf16* qt = (LAS bf16*)F.lds;
    const bf16* XB = (const bf16*)(F.ws + WS_XN); bf16* O2p = (bf16*)(F.ws + WS_O2);
    const bf16* WqT = (const bf16*)(F.ws + WS_WMQ) + (size_t)l * 256 * D;
    const float* qg = (const float*)A.in[31] + l * 64;
    const int lane = F.lane, w = F.wave, r = lane & 15, kq = lane >> 4, hh = lane >> 5, ql = lane & 31;
    for (int pp = xd.rank; pp < xd.U; pp += xd.nloc) { const int tile = 4 * xd.rt0 + pp;
        const size_t m0 = (size_t)tile * 64;
        bf16x8 wa[2][8], wb[2][8];
#define MQ_LOADW(W, kb_) do { _Pragma("unroll") for (int nt_ = 0; nt_ < 2; ++nt_) _Pragma("unroll") for (int ks_ = 0; ks_ < 8; ++ks_) W[nt_][ks_] = *(const bf16x8*)(WqT + (size_t)(32 * w + 16 * nt_ + r) * D + ((kb_) * 8 + ks_) * 32 + kq * 8); asm volatile("" ::: "memory"); } while (0)
        MQ_LOADW(wa, 0);
        __syncthreads();
        xd_wait(cw + (tile >> 2) * 64);
#pragma unroll
        for (int i = 0; i < 16; ++i) { const int p = F.tid + NTHR * i, row = p >> 7, c8 = (p & 127) * 8; *(LAS v4u*)(xa + row * MAP + c8) = *(const v4u*)(XB + (m0 + row) * D + c8); }
        __syncthreads();
        f32x4 acc[4][2];
#pragma unroll
        for (int tq = 0; tq < 4; ++tq) { acc[tq][0] = (f32x4){0.f, 0.f, 0.f, 0.f}; acc[tq][1] = acc[tq][0]; }
        {
#define MQ_LDA(AF, kb_, ks_) do { _Pragma("unroll") for (int tq_ = 0; tq_ < 4; ++tq_) AF[tq_] = *(const LAS bf16x8*)(xa + (16 * tq_ + r) * MAP + ((kb_) * 8 + (ks_)) * 32 + kq * 8); asm volatile("" ::: "memory"); } while (0)
#define MQ_MM8(W, AF, ks_) do { _Pragma("unroll") for (int tq_ = 0; tq_ < 4; ++tq_) { acc[tq_][0] = __builtin_amdgcn_mfma_f32_16x16x32_bf16(W[0][ks_], AF[tq_], acc[tq_][0], 0, 0, 0); acc[tq_][1] = __builtin_amdgcn_mfma_f32_16x16x32_bf16(W[1][ks_], AF[tq_], acc[tq_][1], 0, 0, 0); } } while (0)
#define MQ_MMA(W, kb_) do { bf16x8 afa_[4], afb_[4]; MQ_LDA(afa_, kb_, 0); \
            _Pragma("unroll") for (int k2_ = 0; k2_ < 8; k2_ += 2) { MQ_LDA(afb_, kb_, k2_ + 1); MQ_MM8(W, afa_, k2_); if (k2_ + 2 < 8) MQ_LDA(afa_, kb_, k2_ + 2); MQ_MM8(W, afb_, k2_ + 1); } } while (0)
            MQ_LOADW(wb, 1); MQ_MMA(wa, 0); MQ_LOADW(wa, 2); MQ_MMA(wb, 1); MQ_LOADW(wb, 3); MQ_MMA(wa, 2); MQ_MMA(wb, 3);
#undef MQ_LOADW
#undef MQ_MMA
#undef MQ_LDA
#undef MQ_MM8
        }
        __syncthreads();
#pragma unroll
        for (int tq = 0; tq < 4; ++tq)
#pragma unroll
            for (int nt = 0; nt < 2; ++nt) *(LAS v2u*)(qt + (16 * tq + r) * MQP + 32 * w + 16 * nt + 4 * kq) = pack4(acc[tq][nt]);
        __syncthreads();
        const int h = w >> 1, half = w & 1, bh = (int)(m0 >> 13) * 4 + h;
        const bf16* KF = (const bf16*)(F.ws + WS_MKF) + (size_t)bh * 16384; const bf16* VF = (const bf16*)(F.ws + WS_MVF) + (size_t)bh * 16384;
        bf16x8 qf[4];
        { float q[32]; float ss = 0.f;
#pragma unroll
          for (int s = 0; s < 4; ++s) { const v4u ww = *(const LAS v4u*)(qt + (32 * half + ql) * MQP + h * 64 + 16 * s + 8 * hh);
              q[8 * s] = bflo(ww.x); q[8 * s + 1] = bfhi(ww.x); q[8 * s + 2] = bflo(ww.y); q[8 * s + 3] = bfhi(ww.y); q[8 * s + 4] = bflo(ww.z); q[8 * s + 5] = bfhi(ww.z); q[8 * s + 6] = bflo(ww.w); q[8 * s + 7] = bfhi(ww.w); }
#pragma unroll
          for (int i = 0; i < 32; ++i) ss += q[i] * q[i];
          ss += shx(ss, 32);
          const float rstd = rsqrtf(ss * (1.0f / 64.0f) + EPS) * (0.125f * 1.4426950408889634f);
#pragma unroll
          for (int s = 0; s < 4; ++s) { const int d = 16 * s + 8 * hh; v4u pw;
              pw.x = pk2(q[8 * s] * rstd * qg[d], q[8 * s + 1] * rstd * qg[d + 1]); pw.y = pk2(q[8 * s + 2] * rstd * qg[d + 2], q[8 * s + 3] * rstd * qg[d + 3]);
              pw.z = pk2(q[8 * s + 4] * rstd * qg[d + 4], q[8 * s + 5] * rstd * qg[d + 5]); pw.w = pk2(q[8 * s + 6] * rstd * qg[d + 6], q[8 * s + 7] * rstd * qg[d + 7]);
              qf[s] = __builtin_bit_cast(bf16x8, pw); } }
        f32x16 o[2];
#pragma unroll
        for (int i = 0; i < 16; ++i) { o[0][i] = 0.f; o[1][i] = 0.f; }
        float lrun = 0.f;
#pragma unroll 1
        for (int kt = 0; kt < 4; ++kt) {
            bf16x8 kf[2][4], vf[2][2][2];
#pragma unroll
            for (int sub = 0; sub < 2; ++sub)
#pragma unroll
                for (int s = 0; s < 4; ++s) kf[sub][s] = *(const bf16x8*)(KF + ((((kt * 2 + sub) * 4 + s) * 64 + lane) * 8));
#pragma unroll
            for (int mt = 0; mt < 2; ++mt)
#pragma unroll
                for (int sub = 0; sub < 2; ++sub)
#pragma unroll
                    for (int s2 = 0; s2 < 2; ++s2) vf[mt][sub][s2] = *(const bf16x8*)(VF + (((((kt * 2 + mt) * 2 + sub) * 2 + s2) * 64 + lane) * 8));
            asm volatile("" ::: "memory");
            f32x16 st[2];
#pragma unroll
            for (int i = 0; i < 16; ++i) { st[0][i] = 0.f; st[1][i] = 0.f; }
#pragma unroll
            for (int s = 0; s < 4; ++s) { st[0] = __builtin_amdgcn_mfma_f32_32x32x16_bf16(kf[0][s], qf[s], st[0], 0, 0, 0); st[1] = __builtin_amdgcn_mfma_f32_32x32x16_bf16(kf[1][s], qf[s], st[1], 0, 0, 0); }
            float ps = 0.f;
#pragma unroll
            for (int sub = 0; sub < 2; ++sub)
#pragma unroll
                for (int i = 0; i < 16; ++i) { const float p = __builtin_amdgcn_exp2f(st[sub][i]); st[sub][i] = p; ps += p; }
            lrun += ps;
#pragma unroll
            for (int sub = 0; sub < 2; ++sub)
#pragma unroll
                for (int s2 = 0; s2 < 2; ++s2) { v4u pw; pw.x = pk2(st[sub][8 * s2], st[sub][8 * s2 + 1]); pw.y = pk2(st[sub][8 * s2 + 2], st[sub][8 * s2 + 3]); pw.z = pk2(st[sub][8 * s2 + 4], st[sub][8 * s2 + 5]); pw.w = pk2(st[sub][8 * s2 + 6], st[sub][8 * s2 + 7]);
                    const bf16x8 pf = __builtin_bit_cast(bf16x8, pw);
                    o[0] = __builtin_amdgcn_mfma_f32_32x32x16_bf16(vf[0][sub][s2], pf, o[0], 0, 0, 0); o[1] = __builtin_amdgcn_mfma_f32_32x32x16_bf16(vf[1][sub][s2], pf, o[1], 0, 0, 0); }
        }
        const float lt = lrun + shx(lrun, 32), il = 1.0f / lt;
        const size_t m = m0 + 32 * half + ql;
#pragma unroll
        for (int mt = 0; mt < 2; ++mt)
#pragma unroll
            for (int g = 0; g < 4; ++g) { v2u wv; wv.x = pk2(o[mt][4 * g] * il, o[mt][4 * g + 1] * il); wv.y = pk2(o[mt][4 * g + 2] * il, o[mt][4 * g + 3] * il);
                *(v2u*)(O2p + m * 256 + h * 64 + 32 * mt + 8 * g + 4 * hh) = wv; }
        xd_signal(cd + (tile >> 2) * 64);
    }
    __syncthreads();
}

constexpr int RWP = 1028, RLP = 40;
__device__ __forceinline__ void norm_router(Frame& F, const Args& A, int l, const XDeal xd, unsigned* cw) {
    const float* g = (const float*)A.in[33] + l * D; const bf16* wrf = (const bf16*)(F.ws + WS_WRT) + (size_t)l * 2 * 32 * RW_KS;
    const float* bg = (const float*)A.in[35] + l * 4; const float* be = (const float*)A.in[37] + l * 32;
    int* LIST = (int*)(F.ws + WS_LIST); float* LISTG = (float*)(F.ws + WS_LISTG);
    GAS unsigned* cnt = F.ctl + CW_CNT + l * 32 * 64;
    LAS float* rs = (LAS float*)F.lds;
    LAS float* lg = rs + 64;
    const int n = F.lane & 15, kq = F.lane >> 4;
    bf16x8 wh[4][3], wo[4][3];
#pragma unroll
    for (int ks = 0; ks < 4; ++ks) { const bf16* p = wrf + (size_t)(4 * F.wave + ks) * RW_KS; const int o2 = 1024 + (kq * 4 + (n & 3)) * 8;
        wh[ks][0] = *(const bf16x8*)(p + F.lane * 8); wh[ks][1] = *(const bf16x8*)(p + 512 + F.lane * 8); wh[ks][2] = *(const bf16x8*)(p + o2);
        wo[ks][0] = *(const bf16x8*)(p + 32 * RW_KS + F.lane * 8); wo[ks][1] = *(const bf16x8*)(p + 32 * RW_KS + 512 + F.lane * 8); wo[ks][2] = *(const bf16x8*)(p + 32 * RW_KS + o2); }
    for (int pp = xd.rank; pp < xd.U; pp += xd.nloc) { const int rb = 4 * xd.rt0 + pp;
        const int m0 = rb * 64;
        __syncthreads();
        xd_wait(cw + (rb >> 2) * 64);
        {
            const int mw = m0 + 8 * F.wave; bf16* xnp = (bf16*)(F.ws + WS_XN);
#define NR_LOAD(R, m_) do { _Pragma("unroll") for (int j_ = 0; j_ < 4; ++j_) R[j_] = *(const f32x4*)((const float*)(F.out + (size_t)(m_) * D) + 4 * F.lane + 256 * j_); } while (0)
#define NR_DONE(R, m_, i_) do { float ss_ = 0.f; _Pragma("unroll") for (int j_ = 0; j_ < 4; ++j_) ss_ += (R[j_].x * R[j_].x + R[j_].y * R[j_].y) + (R[j_].z * R[j_].z + R[j_].w * R[j_].w); \
                const float rs_ = rsqrtf(wave_sum(ss_) * (1.0f / 1024.0f) + EPS); if (F.lane == 0) rs[8 * F.wave + (i_)] = rs_; \
                _Pragma("unroll") for (int j_ = 0; j_ < 4; ++j_) { const f32x4 h_ = R[j_] * rs_ * *(const f32x4*)(g + 4 * F.lane + 256 * j_); v2u o_; o_.x = pk2(h_.x, h_.y); o_.y = pk2(h_.z, h_.w); \
                    *(v2u*)(xnp + (size_t)(m_) * D + 4 * F.lane + 256 * j_) = o_; } } while (0)
            f32x4 RA[4], RB[4]; NR_LOAD(RA, mw); NR_LOAD(RB, mw + 1);
#pragma unroll
            for (int st = 0; st < 4; ++st) {
                NR_DONE(RA, mw + 2 * st, 2 * st); NR_DONE(RB, mw + 2 * st + 1, 2 * st + 1);
                const int trow = 8 * (n >> 1) + 2 * st + (n & 1);
                const float* xr = (const float*)(F.out + (size_t)(m0 + trow) * D) + 128 * F.wave + kq * 8;
                f32x4 xv[4][2];
#pragma unroll
                for (int ks = 0; ks < 4; ++ks) { xv[ks][0] = *(const f32x4*)(xr + ks * 32); xv[ks][1] = *(const f32x4*)(xr + ks * 32 + 4); }
                if (st < 3) { NR_LOAD(RA, mw + 2 * st + 2); NR_LOAD(RB, mw + 2 * st + 3); }
                f32x4 a0 = (f32x4){0.f, 0.f, 0.f, 0.f}, a1 = a0, a2 = a0;
#pragma unroll
                for (int ks = 0; ks < 4; ++ks) { v4u xh, xl; const f32x4 p = xv[ks][0], q = xv[ks][1];
                    xh.x = pk2(p.x, p.y); xh.y = pk2(p.z, p.w); xh.z = pk2(q.x, q.y); xh.w = pk2(q.z, q.w);
                    xl.x = pk2(p.x - bflo(xh.x), p.y - bfhi(xh.x)); xl.y = pk2(p.z - bflo(xh.y), p.w - bfhi(xh.y)); xl.z = pk2(q.x - bflo(xh.z), q.y - bfhi(xh.z)); xl.w = pk2(q.z - bflo(xh.w), q.w - bfhi(xh.w));
                    const bf16x8 bh = __builtin_bit_cast(bf16x8, xh), bl = __builtin_bit_cast(bf16x8, xl);
                    a0 = __builtin_amdgcn_mfma_f32_16x16x32_bf16(wh[ks][0], bh, a0, 0, 0, 0); a1 = __builtin_amdgcn_mfma_f32_16x16x32_bf16(wh[ks][1], bh, a1, 0, 0, 0); a2 = __builtin_amdgcn_mfma_f32_16x16x32_bf16(wh[ks][2], bh, a2, 0, 0, 0);
                    a0 = __builtin_amdgcn_mfma_f32_16x16x32_bf16(wo[ks][0], bh, a0, 0, 0, 0); a1 = __builtin_amdgcn_mfma_f32_16x16x32_bf16(wo[ks][1], bh, a1, 0, 0, 0); a2 = __builtin_amdgcn_mfma_f32_16x16x32_bf16(wo[ks][2], bh, a2, 0, 0, 0);
                    a0 = __builtin_amdgcn_mfma_f32_16x16x32_bf16(wh[ks][0], bl, a0, 0, 0, 0); a1 = __builtin_amdgcn_mfma_f32_16x16x32_bf16(wh[ks][1], bl, a1, 0, 0, 0); a2 = __builtin_amdgcn_mfma_f32_16x16x32_bf16(wh[ks][2], bl, a2, 0, 0, 0); }
                LAS float* lrow = lg + (F.wave * 64 + trow) * RLP + 4 * kq;
                *(LAS f32x4*)(lrow) = a0; *(LAS f32x4*)(lrow + 16) = a1; if (kq == 0) *(LAS f32x4*)(lrow + 32) = a2;
            }
#undef NR_LOAD
#undef NR_DONE
        }
        __syncthreads();
        if (F.tid < 64) { const int m = m0 + F.tid; const LAS float* lr = lg + F.tid * RLP; const float sc = rs[F.tid];
            LAS unsigned* lh = (LAS unsigned*)(lg + 8 * 64 * RLP);
            if (F.tid < 32) lh[F.tid] = 0u;
#define LSUM(j_) (((lr[(j_)] + lr[64 * RLP + (j_)]) + (lr[2 * 64 * RLP + (j_)] + lr[3 * 64 * RLP + (j_)])) + ((lr[4 * 64 * RLP + (j_)] + lr[5 * 64 * RLP + (j_)]) + (lr[6 * 64 * RLP + (j_)] + lr[7 * 64 * RLP + (j_)])))
            const float g0 = LSUM(0) * sc + bg[0], g1 = LSUM(1) * sc + bg[1], g2 = LSUM(2) * sc + bg[2], g3 = LSUM(3) * sc + bg[3];
            int gi = 0; float gm = g0; if (g1 > gm) { gm = g1; gi = 1; } if (g2 > gm) { gm = g2; gi = 2; } if (g3 > gm) { gm = g3; gi = 3; }
            const float gwt = 1.0f / (expf(g0 - gm) + expf(g1 - gm) + expf(g2 - gm) + expf(g3 - gm));
            float e[8];
#pragma unroll
            for (int i = 0; i < 8; ++i) e[i] = LSUM(4 + gi * 8 + i) * sc + be[gi * 8 + i];
#undef LSUM
            int i1 = 0; float m1 = e[0];
#pragma unroll
            for (int i = 1; i < 8; ++i) if (e[i] > m1) { m1 = e[i]; i1 = i; }
            int i2 = -1; float m2 = -3.0e38f;
#pragma unroll
            for (int i = 0; i < 8; ++i) if (i != i1 && e[i] > m2) { m2 = e[i]; i2 = i; }
            const float e2 = expf(m2 - m1), den = 1.0f / (1.0f + e2);
            const int ex0 = gi * 8 + i1, ex1 = gi * 8 + i2;
            const unsigned r0 = __hip_atomic_fetch_add(lh + ex0, 1u, __ATOMIC_RELAXED, __HIP_MEMORY_SCOPE_WORKGROUP), r1 = __hip_atomic_fetch_add(lh + ex1, 1u, __ATOMIC_RELAXED, __HIP_MEMORY_SCOPE_WORKGROUP);
            __builtin_amdgcn_fence(__ATOMIC_RELEASE, "wavefront"); __builtin_amdgcn_wave_barrier();
            if (F.tid < 32) { const unsigned c_ = lh[F.tid]; lh[32 + F.tid] = c_ ? __hip_atomic_fetch_add(cnt + F.tid * 64, c_, __ATOMIC_RELAXED, __HIP_MEMORY_SCOPE_AGENT) : 0u; }
            __builtin_amdgcn_fence(__ATOMIC_RELEASE, "wavefront"); __builtin_amdgcn_wave_barrier();
            const unsigned s0 = lh[32 + ex0] + r0, s1 = lh[32 + ex1] + r1;
            LIST[(ex0 << 14) + (int)s0] = 2 * m; LISTG[(ex0 << 14) + (int)s0] = gwt * den; LIST[(ex1 << 14) + (int)s1] = 2 * m + 1; LISTG[(ex1 << 14) + (int)s1] = gwt * e2 * den; }
        __syncthreads();
    }
}

__device__ __forceinline__ void moe_tables(Frame& F, int l) {
    LAS int* T = (LAS int*)(F.lds + TBL_OFF);
    __syncthreads();
    if (F.tid < 64) {
        GAS unsigned* cnt = F.ctl + CW_CNT + l * 32 * 64;
        const int lane = F.tid;
        const int cval = (lane < NEXP) ? (int)__hip_atomic_load(cnt + lane * 64, __ATOMIC_RELAXED, __HIP_MEMORY_SCOPE_AGENT) : 0;
        const int nt = (cval + 255) >> 8;
        int pre = 0;
        { int run = 0;
#pragma unroll 1
          for (int e = 0; e < NEXP; ++e) { run += __builtin_amdgcn_readlane(nt, e); if (lane == e) pre = run; }
          if (lane >= NEXP) pre = run; }
        const int rt0 = pre - nt;
        if (lane < NEXP) { T[lane] = rt0 * 256; T[256 + lane] = cval; for (int i = 0; i < nt; ++i) T[64 + rt0 + i] = lane; }
        if (lane == NEXP - 1) T[32] = pre;
    }
    __syncthreads();
}

#ifndef MOE_ALIGN
#define MOE_ALIGN true
#endif
#ifndef MOE_SP2
#define MOE_SP2 true
#endif
constexpr int NPH = 14;
__global__ void __launch_bounds__(NTHR, 2) fwd_kernel(Args args) {
    extern __shared__ __attribute__((aligned(16))) unsigned char lds[];
    Frame F;
    F.lds = (LAS unsigned char*)lds; F.MISC = (volatile LAS unsigned*)(F.lds + MISC_OFF);
    F.tid = threadIdx.x; F.lane = F.tid & 63; F.wave = __builtin_amdgcn_readfirstlane(F.tid >> 6); F.bid = blockIdx.x; F.G = gridDim.x;
    F.ws = (GAS unsigned char*)args.ws; F.out = (GAS float*)args.out; F.ctl = (GAS unsigned*)(args.ws + WS_CTL);
    for (int u = F.tid; u < (LDS_BYTES - LDSCTL_OFF) / 4; u += NTHR) ((LAS unsigned*)(F.lds + LDSCTL_OFF))[u] = 0u;
    __syncthreads();
    const int lo = args.ph_lo, hi = args.ph_hi;
    const bool multi = (hi - lo) > 1;
    XcdBarrier bar; bar.bar = (unsigned*)(F.ctl + CW_BAR); bar.x = 0; bar.st = nullptr;
    if (multi) bar = xcd_barrier_post((unsigned*)(F.ctl + CW_BAR), F.MISC + 8);
#ifndef PHASE_MASK
#define PHASE_MASK 0xFFFFFFFFu
#endif
#define PH_ON(k) (((PHASE_MASK) >> (k)) & 1u)
#ifndef REP_MASK
#define REP_MASK 0u
#endif
#ifndef REP_N
#define REP_N 2
#endif
#define REPS(k) for (int rep_ = 0; rep_ < ((((REP_MASK) >> (k)) & 1u) ? REP_N : 1); ++rep_)
#define IN(k) (lo <= (k) && (k) < hi)
#define SEAM(k) do { if (IN(k) && IN((k) + 1)) xcd_barrier<false>(bar); } while (0)
#define SEAM_LIGHT(k) do { if (IN(k) && IN((k) + 1)) xcd_barrier<true>(bar); } while (0)
#define LAUNDER() do { asm volatile("" : "+s"(F.ws), "+s"(F.out), "+s"(F.ctl)); { int t_ = threadIdx.x; asm volatile("" : "+v"(t_)); F.tid = t_; } F.lane = F.tid & 63; F.wave = __builtin_amdgcn_readfirstlane(F.tid >> 6); } while (0)
    LAS unsigned char* ring = F.lds;
#define XN ((bf16*)(F.ws + WS_XN))
#define MIX ((bf16*)(F.ws + WS_MIX))
#define PROJ ((bf16*)(F.ws + WS_PROJ))
#define Q2 ((bf16*)(F.ws + WS_Q2))
#define O2 ((bf16*)(F.ws + WS_O2))
#define HS ((bf16*)(F.ws + WS_HS))
#define HH ((bf16*)(F.ws + WS_H))
#define YM ((bf16*)(F.ws + WS_YM))

    if (PH_ON(14) && IN(0)) REPS(14) { LAUNDER(); p0_prologue(F, args); }
    SEAM(0);
    for (int l = 0; l < DEPTH; ++l) {
        const int pb = 1 + l * NPH;
        if (PH_ON(0) && IN(pb + 0)) REPS(0) {
#define XD1_SETUP() LAUNDER(); const int nloc_ = __builtin_amdgcn_readfirstlane((int)F.MISC[8]), nx_ = __builtin_amdgcn_readfirstlane((int)F.MISC[9]), xi_ = __builtin_amdgcn_readfirstlane((int)F.MISC[10]), rank_ = __builtin_amdgcn_readfirstlane((int)F.MISC[11]); \
            const int rtA_ = (xi_ * 64) / nx_, rtB_ = ((xi_ + 1) * 64) / nx_; const XDeal xd{rtA_, 4 * (rtB_ - rtA_), rank_, nloc_}; unsigned* c1 = (unsigned*)(F.ctl + CW_XC + (8 + l) * 64 * 64); (void)xd; (void)c1
            { LAUNDER();
              if (l == 0) { pg8::Gemm g{(const bf16*)(F.ws + WS_MN), (const bf16*)(F.ws + WS_WMKV), 512, 512, D}; pg8::StaticOrder S; S.init(512, 512, F.G, F.bid);
                  pg8::EpiF32 E{(float*)(F.ws + WS_MKV), 512}; pg8::gemm_phase<pg8::EpiF32, pg8::StaticOrder, true, true>(ring, g, S, E); } }
            { XD1_SETUP();
              if (l > 0) { unsigned* c14p = (unsigned*)(F.ctl + CW_XC + (10 + l - 1) * 64 * 64);
                  for (int p = xd.rank; p < 11 * (rtB_ - rtA_); p += xd.nloc) xd_wait(c14p + (xd.rt0 + p / 11) * 64); }
              pg8::Gemm g{XN, (const bf16*)(F.ws + WS_WIN) + (size_t)l * NINP * D, M, NINP, D};
              pg8::XOrder S{xd.rt0, 11 * (rtB_ - rtA_), xd.rank, xd.nloc, c1, 11};
              pg8::EpiBf16<0> E{PROJ, NINP, nullptr, 0, 0, 1.f, (rtB_ < 64 && (rtB_ & 31) != 0) ? rtB_ - 1 : -1};
              pg8::gemm_phase<pg8::EpiBf16<0>, pg8::XOrder, true, true>(ring, g, S, E); S.flush(); }
            { XD1_SETUP(); if (l > 0) xd_wait_blocks((unsigned*)(F.ctl + CW_XC + 12 * 64 * 64 + (l - 1) * 64), (unsigned)F.G);
              rwkv_prep(F, args, l, xd, c1); }
            { XD1_SETUP(); mla_prep(F, args, l, xd); }
            { XD1_SETUP(); gmlp_stage(F, args, l, xd); }
#undef XD1_SETUP
        }
        SEAM(pb + 0);
        if (PH_ON(2) && IN(pb + 2)) REPS(2) { LAUNDER();
            if (l == 0) memkv_arrange(F, args); LAUNDER(); rwkv_state_scan(F); attn_mfma(F); }
        SEAM(pb + 2);
        if (PH_ON(4) && IN(pb + 4)) REPS(4) {
#define XD_SETUP() LAUNDER(); const int nloc_ = __builtin_amdgcn_readfirstlane((int)F.MISC[8]), nx_ = __builtin_amdgcn_readfirstlane((int)F.MISC[9]), xi_ = __builtin_amdgcn_readfirstlane((int)F.MISC[10]), rank_ = __builtin_amdgcn_readfirstlane((int)F.MISC[11]); \
            const int rtA_ = (xi_ * 64) / nx_, rtB_ = ((xi_ + 1) * 64) / nx_; const XDeal xd{rtA_, 4 * (rtB_ - rtA_), rank_, nloc_}; \
            unsigned* c5 = (unsigned*)(F.ctl + CW_XC + (l * 3 + 0) * 64 * 64); unsigned* c7 = (unsigned*)(F.ctl + CW_XC + (l * 3 + 1) * 64 * 64); unsigned* c9 = (unsigned*)(F.ctl + CW_XC + (l * 3 + 2) * 64 * 64); unsigned* c4 = (unsigned*)(F.ctl + CW_XC + (6 + l) * 64 * 64); (void)c4; (void)c5; (void)c7; (void)c9
            { XD_SETUP(); attn_merge(F, xd); }
            { XD_SETUP(); rwkv_out(F, args, l, xd, c4); }
            { XD_SETUP(); for (int pp = xd.rank; pp < xd.U; pp += xd.nloc) xd_wait(c4 + (xd.rt0 + (pp >> 2)) * 64);
              pg8::Gemm g{MIX, (const bf16*)(F.ws + WS_WOUT) + (size_t)l * D * D, M, D, D}; pg8::XOrder S{xd.rt0, xd.U, xd.rank, xd.nloc, c5};
              pg8::EpiResXB E{l == 0 ? (const float*)args.in[0] : (const float*)F.out, (float*)F.out, XN, D};
              pg8::gemm_phase<pg8::EpiResXB, pg8::XOrder, true, true>(ring, g, S, E); S.flush(); }
            { XD_SETUP(); mem_q_attn(F, args, l, xd, c5, c7); }
            { XD_SETUP(); for (int pp = xd.rank; pp < xd.U; pp += xd.nloc) xd_wait(c7 + (xd.rt0 + (pp >> 2)) * 64);
              pg8::Gemm g{O2, (const bf16*)(F.ws + WS_WMO) + (size_t)l * D * 256, M, D, 256}; pg8::XOrder S{xd.rt0, xd.U, xd.rank, xd.nloc, c9};
              pg8::EpiResF32 E{(const float*)F.out, (float*)F.out, D};
              pg8::gemm_phase<pg8::EpiResF32, pg8::XOrder, true, true>(ring, g, S, E); S.flush(); }
            { XD_SETUP(); norm_router(F, args, l, xd, c9); }
#undef XD_SETUP
        }
        SEAM(pb + 4);
        if (PH_ON(11) && IN(pb + 11)) REPS(11) { LAUNDER(); moe_tables(F, l); const LAS int* T = (const LAS int*)(F.lds + TBL_OFF);
            const int nrt = __builtin_amdgcn_readfirstlane(T[32]);
            const int nloc = __builtin_amdgcn_readfirstlane((int)F.MISC[8]), nx = __builtin_amdgcn_readfirstlane((int)F.MISC[9]), xi = __builtin_amdgcn_readfirstlane((int)F.MISC[10]), rank = __builtin_amdgcn_readfirstlane((int)F.MISC[11]);
            const int rtA = (xi * nrt) / nx, rtB = ((xi + 1) * nrt) / nx;
            pg8::MoeOrderX S{rtA, 4 * (rtB - rtA), rank, nloc, 0, (const PG8_LAS int*)(T + 64), (unsigned*)(F.ctl + CW_MD + l * 160 * 64)};
            LAS unsigned* GT = (LAS unsigned*)(F.lds + GT_OFF);
            { const int* LIST = (const int*)(F.ws + WS_LIST);
              static_assert(GT_UNITS == 4, "two table entries per thread");
              int a_[2]; bool ok_[2]; int tg_ = F.tid; asm volatile("" : "+v"(tg_)); const int uh_ = __builtin_amdgcn_readfirstlane(tg_ >> 8), rw_ = tg_ & 255;
#pragma unroll
              for (int k = 0; k < 2; ++k) { const int ui = uh_ + 2 * k; pg8::Unit u; ok_[k] = S.next(ui, u); a_[k] = 0;
                  if (ok_[k]) { const int e = u.pn >> 2, loc = u.pm * 256 - T[e] + rw_; if (loc < T[256 + e]) a_[k] = LIST[(e << 14) + loc]; } }
#pragma unroll
              for (int k = 0; k < 2; ++k) if (ok_[k]) GT[(uh_ + 2 * k) * 256 + rw_] = (unsigned)(a_[k] >> 1) * (unsigned)(D * 2);
              __syncthreads(); }
            { pg8::Gemm g{(const bf16*)(F.ws + WS_XN), (const bf16*)(F.ws + WS_W13) + (size_t)l * NEXP * 1024 * D, PROWS, 1024, D, (const PG8_LAS unsigned*)GT};
              pg8::EpiSwiGLU E{HH, 512};
              pg8::gemm_phase<pg8::EpiSwiGLU, pg8::MoeOrderX, MOE_ALIGN, MOE_SP2, true>(ring, g, S, E); }
            { pg8::MoeOrderX S2 = S; S2.mode = 1;
              pg8::Gemm g{HH, (const bf16*)(F.ws + WS_W2) + (size_t)l * NEXP * D * 512, PROWS, 1024, 512};
              pg8::EpiMoeOut E{YM, (const int*)(F.ws + WS_LIST), (const float*)(F.ws + WS_LISTG), (const PG8_LAS int*)T};
              pg8::gemm_phase<pg8::EpiMoeOut, pg8::MoeOrderX, MOE_ALIGN, MOE_SP2>(ring, g, S2, E); }
        }
        SEAM(pb + 11);
        if (PH_ON(13) && IN(pb + 13)) REPS(13) { LAUNDER();
            const int nloc_ = __builtin_amdgcn_readfirstlane((int)F.MISC[8]), nx_ = __builtin_amdgcn_readfirstlane((int)F.MISC[9]), xi_ = __builtin_amdgcn_readfirstlane((int)F.MISC[10]), rank_ = __builtin_amdgcn_readfirstlane((int)F.MISC[11]);
            const int rtA_ = (xi_ * 64) / nx_, rtB_ = ((xi_ + 1) * 64) / nx_; unsigned* c14 = (unsigned*)(F.ctl + CW_XC + (10 + l) * 64 * 64);
            const float* gnx = l + 1 < DEPTH ? (const float*)args.in[3] + (l + 1) * D : nullptr;
            struct Row { f32x4 x[4]; v2u a[4], b[4]; };
#define ROW_LOAD(R, m_) do { const float* xi_ = (const float*)(F.out + (size_t)(m_) * D); const bf16* y0_ = YM + (size_t)(2 * (m_)) * D; const bf16* y1_ = y0_ + D; _Pragma("unroll") for (int j_ = 0; j_ < 4; ++j_) { \
                R.x[j_] = *(const f32x4*)(xi_ + 4 * F.lane + 256 * j_); R.a[j_] = *(const v2u*)(y0_ + 4 * F.lane + 256 * j_); R.b[j_] = *(const v2u*)(y1_ + 4 * F.lane + 256 * j_); } } while (0)
#define ROW_DONE(R, m_) do { float ss_ = 0.f; f32x4 v_[4]; _Pragma("unroll") for (int j_ = 0; j_ < 4; ++j_) { f32x4 t_ = R.x[j_]; \
                t_.x += bflo(R.a[j_].x) + bflo(R.b[j_].x); t_.y += bfhi(R.a[j_].x) + bfhi(R.b[j_].x); t_.z += bflo(R.a[j_].y) + bflo(R.b[j_].y); t_.w += bfhi(R.a[j_].y) + bfhi(R.b[j_].y); \
                *(f32x4*)((float*)(F.out + (size_t)(m_) * D) + 4 * F.lane + 256 * j_) = t_; v_[j_] = t_; ss_ += (t_.x * t_.x + t_.y * t_.y) + (t_.z * t_.z + t_.w * t_.w); } \
                if (gnx) { const float rs_ = rsqrtf(wave_sum(ss_) * (1.0f / 1024.0f) + EPS); _Pragma("unroll") for (int j_ = 0; j_ < 4; ++j_) { const f32x4 h_ = v_[j_] * rs_ * *(const f32x4*)(gnx + 4 * F.lane + 256 * j_); \
                    v2u o_; o_.x = pk2(h_.x, h_.y); o_.y = pk2(h_.z, h_.w); *(v2u*)(XN + (size_t)(m_) * D + 4 * F.lane + 256 * j_) = o_; } } } while (0)
#pragma unroll 1
            for (int pp = rank_; pp < 4 * (rtB_ - rtA_); pp += nloc_) { const int tile = 4 * rtA_ + pp, mw = tile * 64 + 8 * F.wave;
                Row RA, RB; ROW_LOAD(RA, mw);
#pragma unroll
                for (int i = 0; i < 8; i += 2) { ROW_LOAD(RB, mw + i + 1); ROW_DONE(RA, mw + i); if (i + 2 < 8) ROW_LOAD(RA, mw + i + 2); ROW_DONE(RB, mw + i + 1); }
                if (gnx) xd_signal(c14 + (tile >> 2) * 64); }
            if (gnx) { __syncthreads(); xd_block_done((unsigned*)(F.ctl + CW_XC + 12 * 64 * 64 + l * 64)); }
#undef ROW_LOAD
#undef ROW_DONE
        }
    }
#undef IN
#undef SEAM
#undef XN
#undef MIX
#undef PROJ
#undef Q2
#undef O2
#undef HS
#undef HH
#undef YM
}

#ifndef N_LAUNCH_MODE
#define N_LAUNCH_MODE 1
#endif
extern "C" void kernel_launch(void* const* d_in, const int* in_sizes, int n_in, void* d_out, int out_size, void* d_ws, size_t ws_size, hipStream_t stream) {
    static int grid = 0;
    if (grid == 0) {
        if (n_in != 41 || in_sizes[0] != M * D || out_size != M * D || ws_size < (size_t)512 * MiB) { fprintf(stderr, "kernel_launch: unexpected shapes (n_in %d, ws %zu)\n", n_in, ws_size); grid = -1; return; }
        int dev = 0, cus = 0;
        if (hipGetDevice(&dev) != hipSuccess || hipDeviceGetAttribute(&cus, hipDeviceAttributeMultiprocessorCount, dev) != hipSuccess) { grid = -1; return; }
        if (hipFuncSetAttribute((const void*)fwd_kernel, hipFuncAttributeMaxDynamicSharedMemorySize, LDS_BYTES) != hipSuccess) { grid = -1; return; }
        int per_cu = 0;
        if (hipOccupancyMaxActiveBlocksPerMultiprocessor(&per_cu, (const void*)fwd_kernel, NTHR, LDS_BYTES) != hipSuccess || per_cu < 1) { fprintf(stderr, "kernel_launch: occupancy query says %d\n", per_cu); }
        (void)hipGetLastError();
        grid = cus;
    }
    if (grid < 0) return;
    (void)hipMemsetAsync((char*)d_ws + WS_CTL, 0, CTL_ZERO_BYTES, stream);
    Args a{};
    for (int i = 0; i < 41; ++i) a.in[i] = d_in[i];
    a.out = (float*)d_out; a.ws = (unsigned char*)d_ws;
    const int nph = 1 + DEPTH * NPH;
    if (N_LAUNCH_MODE == 1) { a.ph_lo = 0; a.ph_hi = nph; hipLaunchKernelGGL(fwd_kernel, dim3(grid), dim3(NTHR), LDS_BYTES, stream, a); }
    else for (int p = 0; p < nph; ++p) { a.ph_lo = p; a.ph_hi = p + 1; hipLaunchKernelGGL(fwd_kernel, dim3(grid), dim3(NTHR), LDS_BYTES, stream, a); }
}
```
